# Optimizing an MI355X kernel written in HIP

```python
import jax, jax.numpy as jnp
from jax import lax
import numpy as np

D_MODEL = 2048
BATCH = 4
SEQ = 2048
DEPTH = 1

CONV_DIM = 1024
CONV_GROUPS = 16
CONV_WIDTH = 3
N_HEADS = 8
HEAD_DIM = 128
ATTN_DIM = N_HEADS * HEAD_DIM
MIX_DIM = CONV_DIM + ATTN_DIM
KV_RANK = 512
IDX_HEADS = 16
IDX_DIM = 128
TOPK_MAX = 256
Q_BLOCK = 128
N_GROUPS = 4
EXPERTS_PER_GROUP = 8
N_EXPERTS = N_GROUPS * EXPERTS_PER_GROUP
TOPK_EXPERTS = 2
EXPERT_FF = 512
N_MOD = 6
EPS = 1e-6

OFF_B = 0
OFF_C = OFF_B + CONV_DIM
OFF_X = OFF_C + CONV_DIM
OFF_Q = OFF_X + CONV_DIM
OFF_KV = OFF_Q + ATTN_DIM
OFF_IQ = OFF_KV + KV_RANK
OFF_IK = OFF_IQ + IDX_HEADS * IDX_DIM
OFF_IW = OFF_IK + IDX_DIM
IN_COLS = OFF_IW + IDX_HEADS

kernel_name = "hymba_conv_dsa_hmoe_adaln"


def rmsnorm(x, g):
    xf = x.astype(jnp.float32)
    y = xf * lax.rsqrt(jnp.mean(xf * xf, axis=-1, keepdims=True) + EPS)
    return (y * g.astype(jnp.float32)).astype(x.dtype)


def causal_dwconv(u, w):
    return lax.conv_general_dilated(
        u, w[:, None, :], window_strides=(1,), padding=[(CONV_WIDTH - 1, 0)],
        dimension_numbers=('NWC', 'WIO', 'NWC'), feature_group_count=u.shape[-1])


def dsa_attention(q_lat, iq, iw, ik, ckv):
    B, S = q_lat.shape[0], q_lat.shape[1]
    k_sel = min(TOPK_MAX, S // 4)
    nb = S // Q_BLOCK
    scale = HEAD_DIM ** -0.5
    key_pos = jnp.arange(S, dtype=jnp.int32)
    q_pos = key_pos.reshape(nb, Q_BLOCK)

    def to_blocks(a):
        return jnp.moveaxis(a.reshape((B, nb, Q_BLOCK) + a.shape[2:]), 1, 0)

    def block(args):
        ql, qi, wi, qp = args
        s_idx = jnp.einsum('bqhd,bsd->bqhs', qi, ik, preferred_element_type=jnp.float32)
        idx_score = jnp.einsum('bqhs,bqh->bqs', jax.nn.relu(s_idx), wi.astype(jnp.float32))
        causal = key_pos[None, :] <= qp[:, None]
        idx_score = jnp.where(causal[None], idx_score, -jnp.inf)
        _, sel = lax.top_k(idx_score, k_sel)
        valid = sel <= qp[None, :, None]
        kv = jax.vmap(lambda cb, ib: cb[ib])(ckv, sel)
        logits = jnp.einsum('bqhr,bqkr->bqhk', ql, kv, preferred_element_type=jnp.float32) * scale
        logits = jnp.where(valid[:, :, None, :], logits, -jnp.inf)
        p = jax.nn.softmax(logits, axis=-1).astype(kv.dtype)
        return jnp.einsum('bqhk,bqkr->bqhr', p, kv)

    o = lax.map(block, (to_blocks(q_lat), to_blocks(iq), to_blocks(iw), q_pos))
    return jnp.moveaxis(o, 0, 1).reshape(B, S, N_HEADS, KV_RANK)


def hier_moe(h, w_rg, b_rg, w_re, b_re, w_gate, w_up, w_down):
    B, S, D = h.shape
    t = h.reshape(-1, D)
    g_prob = jax.nn.softmax((t @ w_rg).astype(jnp.float32) + b_rg.astype(jnp.float32), axis=-1)
    p_group, g_sel = lax.top_k(g_prob, 1)
    e_logits = ((t @ w_re).astype(jnp.float32) + b_re.astype(jnp.float32)).reshape(-1, N_GROUPS, EXPERTS_PER_GROUP)
    e_logits = jnp.take_along_axis(e_logits, g_sel[:, :, None], axis=1)[:, 0]
    top_p, top_i = lax.top_k(jax.nn.softmax(e_logits, axis=-1), TOPK_EXPERTS)
    top_p = top_p / jnp.sum(top_p, axis=-1, keepdims=True)
    within = jnp.einsum('tk,tke->te', top_p, jax.nn.one_hot(top_i, EXPERTS_PER_GROUP, dtype=jnp.float32))
    combine = (jax.nn.one_hot(g_sel[:, 0], N_GROUPS, dtype=jnp.float32)[:, :, None]
               * (p_group * within)[:, None, :]).reshape(-1, N_EXPERTS).astype(t.dtype)
    out = jnp.zeros_like(t)
    for g in range(N_GROUPS):
        sl = slice(g * EXPERTS_PER_GROUP, (g + 1) * EXPERTS_PER_GROUP)
        a = jnp.einsum('td,edf->tef', t, w_gate[sl])
        u = jnp.einsum('td,edf->tef', t, w_up[sl])
        hid = jax.nn.silu(a) * u * combine[:, sl, None]
        out = out + jnp.einsum('tef,efd->td', hid, w_down[sl])
    return out.reshape(B, S, D)


def setup_inputs(seed: int = 0) -> dict:
    key = jax.random.key(seed)
    ks = jax.random.split(key, 24)
    f = jnp.float32
    L, D = DEPTH, D_MODEL

    def nrm(k, shape, std):
        return jax.random.normal(k, shape, f) * std

    def gain(k, shape):
        return 1.0 + 0.02 * jax.random.normal(k, shape, f)

    return {
        "x": nrm(ks[0], (BATCH, SEQ, D), 1.0),
        "c": nrm(ks[1], (BATCH, D), 1.0),
        "w_ada": nrm(ks[2], (L, D, N_MOD * D), 0.5 * D ** -0.5),
        "b_ada": nrm(ks[3], (L, N_MOD * D), 0.02),
        "g_mix": gain(ks[4], (L, D)),
        "w_in": nrm(ks[5], (L, D, IN_COLS), D ** -0.5),
        "conv_w": nrm(ks[6], (L, CONV_WIDTH, CONV_DIM), CONV_WIDTH ** -0.5),
        "w_uk": nrm(ks[7], (L, N_HEADS, KV_RANK, HEAD_DIM), KV_RANK ** -0.5),
        "kv_norm_g": gain(ks[8], (L, KV_RANK)),
        "w_uv": nrm(ks[9], (L, N_HEADS, KV_RANK, HEAD_DIM), KV_RANK ** -0.5),
        "g_conv_out": gain(ks[10], (L, CONV_DIM)),
        "g_attn_out": gain(ks[11], (L, ATTN_DIM)),
        "w_out": nrm(ks[12], (L, MIX_DIM, D), MIX_DIM ** -0.5),
        "g_ffn": gain(ks[13], (L, D)),
        "w_rg": nrm(ks[14], (L, D, N_GROUPS), D ** -0.5),
        "b_rg": nrm(ks[15], (L, N_GROUPS), 0.01),
        "w_re": nrm(ks[16], (L, D, N_EXPERTS), D ** -0.5),
        "b_re": nrm(ks[17], (L, N_EXPERTS), 0.01),
        "w_gate": nrm(ks[18], (L, N_EXPERTS, D, EXPERT_FF), D ** -0.5),
        "w_up": nrm(ks[19], (L, N_EXPERTS, D, EXPERT_FF), D ** -0.5),
        "w_down": nrm(ks[20], (L, N_EXPERTS, EXPERT_FF, D), EXPERT_FF ** -0.5),
        "w_ada_f": nrm(ks[21], (D, 2 * D), 0.5 * D ** -0.5),
        "b_ada_f": nrm(ks[22], (2 * D,), 0.02),
        "g_final": gain(ks[23], (D,)),
    }


def reference(x, c, w_ada, b_ada, g_mix, w_in, conv_w, w_uk, kv_norm_g, w_uv, g_conv_out, g_attn_out,
              w_out, g_ffn, w_rg, b_rg, w_re, b_re, w_gate, w_up, w_down, w_ada_f, b_ada_f, g_final):
    B, S, D = x.shape
    c_act = jax.nn.silu(c)
    for l in range(DEPTH):
        mod = (c_act @ w_ada[l] + b_ada[l])[:, None, :]
        sh1, sc1, gt1, sh2, sc2, gt2 = jnp.split(mod, N_MOD, axis=-1)

        h = rmsnorm(x, g_mix[l]) * (1.0 + sc1) + sh1
        proj = h @ w_in[l]

        bg = proj[..., OFF_B:OFF_C]
        cg = proj[..., OFF_C:OFF_X]
        xv = proj[..., OFF_X:OFF_Q]
        y_conv = bg * causal_dwconv(cg * xv, conv_w[l])

        q = proj[..., OFF_Q:OFF_KV].reshape(B, S, N_HEADS, HEAD_DIM)
        ckv = rmsnorm(proj[..., OFF_KV:OFF_IQ], kv_norm_g[l])
        iq = proj[..., OFF_IQ:OFF_IK].reshape(B, S, IDX_HEADS, IDX_DIM)
        ik = proj[..., OFF_IK:OFF_IW]
        iw = proj[..., OFF_IW:IN_COLS] * (IDX_HEADS ** -0.5 * IDX_DIM ** -0.5)
        q_lat = jnp.einsum('bshd,hrd->bshr', q, w_uk[l])
        o_lat = dsa_attention(q_lat, iq, iw, ik, ckv)
        y_attn = jnp.einsum('bshr,hrd->bshd', o_lat, w_uv[l]).reshape(B, S, ATTN_DIM)

        mix = jnp.concatenate([rmsnorm(y_conv, g_conv_out[l]), rmsnorm(y_attn, g_attn_out[l])], axis=-1)
        x = x + gt1 * (mix @ w_out[l])

        h2 = rmsnorm(x, g_ffn[l]) * (1.0 + sc2) + sh2
        x = x + gt2 * hier_moe(h2, w_rg[l], b_rg[l], w_re[l], b_re[l], w_gate[l], w_up[l], w_down[l])

    modf = (c_act @ w_ada_f + b_ada_f)[:, None, :]
    shf, scf = jnp.split(modf, 2, axis=-1)
    return rmsnorm(x, g_final) * (1.0 + scf) + shf
```

```cpp
#include <hip/hip_runtime.h>
#include <stdint.h>
#include <stdio.h>

typedef _Float16 half_t;
typedef _Float16 half8 __attribute__((ext_vector_type(8)));
typedef _Float16 half4 __attribute__((ext_vector_type(4)));
typedef _Float16 half2v __attribute__((ext_vector_type(2)));
typedef float f32x4 __attribute__((ext_vector_type(4)));
typedef float f32x16 __attribute__((ext_vector_type(16)));
typedef unsigned u32x4 __attribute__((ext_vector_type(4)));

#define NT 512
#define XCC_RANK 4096
#define LAS __attribute__((address_space(3)))
constexpr int D = 2048, SEQ = 2048, NTOK = 8192;
constexpr int NPAD = 6912;
constexpr int OFF_B = 0, OFF_C = 1024, OFF_X = 2048, OFF_Q = 3072, OFF_KV = 4096, OFF_IQ = 4608, OFF_IK = 6656, OFF_IW = 6784;
constexpr int IN_COLS = 6800;
constexpr float EPS = 1e-6f;
constexpr float IWSCALE = 0.02209708691207961f;
constexpr float QSCALE = 0.12751743f;
constexpr int KSPLIT = 16;
constexpr int MODN = 16384;
constexpr int TM = 256;
constexpr int SLOTS = 24576;

constexpr size_t al(size_t x) { return (x + 255) & ~(size_t)255; }
constexpr size_t WS_BAR = 0;
constexpr size_t WS_PART = 65536;
constexpr size_t WS_MOD = WS_PART + al((size_t)KSPLIT * 4 * MODN * 4);
constexpr size_t WS_H16 = WS_MOD + al((size_t)4 * MODN * 4);
constexpr size_t WS_WIN16 = WS_H16 + al((size_t)NTOK * D * 2);
constexpr size_t WS_PROJ16 = WS_WIN16 + al((size_t)NPAD * D * 2);
constexpr size_t WS_CKV16 = WS_PROJ16 + al((size_t)NTOK * NPAD * 2);
constexpr size_t WS_QLAT16 = WS_CKV16 + al((size_t)NTOK * 512 * 2);
constexpr size_t WS_SCORE = WS_QLAT16 + al((size_t)NTOK * 4096 * 2);
constexpr size_t WS_SEL = WS_SCORE + al((size_t)NTOK * 2048 * 4);
constexpr size_t WS_NSEL = WS_SEL + al((size_t)NTOK * 256 * 2);
constexpr size_t WS_WOUT16 = WS_NSEL + al((size_t)NTOK * 4);
constexpr size_t WS_WUK16 = WS_WOUT16 + al((size_t)D * D * 2);
constexpr size_t WS_WUV16 = WS_WUK16 + al((size_t)8 * 512 * 128 * 2);
constexpr size_t WS_WR16 = WS_WUV16 + al((size_t)8 * 512 * 128 * 2);
constexpr size_t WS_WGU16 = WS_WR16 + al((size_t)64 * D * 2);
constexpr size_t WS_WD16 = WS_WGU16 + al((size_t)32 * 1024 * D * 2);
constexpr size_t WS_ACT16 = WS_WD16 + al((size_t)32 * D * 512 * 2);
constexpr size_t WS_ROUTE = WS_ACT16 + al((size_t)SLOTS * 512 * 2);
constexpr size_t WS_BLKCNT = WS_ROUTE + al((size_t)NTOK * 32);
constexpr size_t WS_ROWMAP = WS_BLKCNT + al((size_t)256 * 32 * 4);
constexpr size_t WS_CSLOT = WS_ROWMAP + al((size_t)SLOTS * 4);
constexpr size_t WS_META = WS_CSLOT + al((size_t)SLOTS * 4);
constexpr size_t WS_END = WS_META + 4096;
constexpr size_t WS_MIX16 = WS_H16;
constexpr size_t WS_OSAVE = WS_SCORE;
constexpr size_t WS_H2_16 = WS_PROJ16;
constexpr size_t WS_MASK = WS_SEL;
constexpr size_t WS_X1H = WS_SCORE + 33554432;
constexpr size_t WS_OUT2 = WS_PROJ16 + al((size_t)NTOK * D * 2);
constexpr size_t WS_H2S = WS_QLAT16;

constexpr int LDS_MAIN = 156672;
constexpr int LDS_BYTES = LDS_MAIN + 16;

struct Params {
  const float *x, *c, *w_ada, *b_ada, *g_mix, *w_in, *conv_w, *w_uk, *kv_norm_g, *w_uv, *g_conv_out, *g_attn_out, *w_out, *g_ffn,
      *w_rg, *b_rg, *w_re, *b_re, *w_gate, *w_up, *w_down, *w_ada_f, *b_ada_f, *g_final;
  float* out;
  char* ws;
  int ph_lo, ph_hi, sub, pad;
};
struct Route { int e1, e2; float c1, c2; int r1, r2; int pad0, pad1; };

__device__ __forceinline__ float wave_sum(float v) {
#pragma unroll
  for (int o = 32; o >= 1; o >>= 1) v += __shfl_xor(v, o);
  return v;
}
__device__ __forceinline__ float wave_max(float v) {
#pragma unroll
  for (int o = 32; o >= 1; o >>= 1) v = fmaxf(v, __shfl_xor(v, o));
  return v;
}
#define LDS_BARRIER() do { asm volatile("s_waitcnt lgkmcnt(0)" ::: "memory"); __builtin_amdgcn_s_barrier(); asm volatile("" ::: "memory"); } while (0)
__device__ __forceinline__ void wave_lds_sync() { asm volatile("s_waitcnt lgkmcnt(0)" ::: "memory"); }

__device__ void p0_modpart(const Params& p, char* lds, int item) {
  const int tid = threadIdx.x;
  float* cact = (float*)lds;
  f32x4* xch = (f32x4*)(lds + 2048);
  const int cb = item & 15, ks = item >> 4, k0 = ks * 128;
  const int col = cb * 1024 + (tid & 255) * 4, rh = tid >> 8;
  __syncthreads();
  { const int b = tid >> 7, kk = tid & 127; const float v = p.c[b * D + k0 + kk]; cact[tid] = v / (1.0f + __expf(-v)); }
  __syncthreads();
  const float* w; int ld;
  if (col < 12288) { w = p.w_ada + col; ld = 12288; } else { w = p.w_ada_f + (col - 12288); ld = 4096; }
  w += (size_t)(k0 + rh * 64) * ld;
  const float* ca = cact + rh * 64;
  f32x4 a0 = (f32x4){0.f, 0.f, 0.f, 0.f}, a1 = a0, a2 = a0, a3 = a0;
#pragma unroll 16
  for (int kk = 0; kk < 64; ++kk) {
    const f32x4 wv = __builtin_nontemporal_load((const f32x4*)(w + (size_t)kk * ld));
    a0 += wv * ca[kk]; a1 += wv * ca[128 + kk]; a2 += wv * ca[256 + kk]; a3 += wv * ca[384 + kk];
  }
  if (rh) { xch[(tid & 255) * 4 + 0] = a0; xch[(tid & 255) * 4 + 1] = a1; xch[(tid & 255) * 4 + 2] = a2; xch[(tid & 255) * 4 + 3] = a3; }
  __syncthreads();
  if (!rh) {
    float* part = (float*)(p.ws + WS_PART);
    *(f32x4*)(part + (size_t)(ks * 4 + 0) * MODN + col) = a0 + xch[tid * 4 + 0]; *(f32x4*)(part + (size_t)(ks * 4 + 1) * MODN + col) = a1 + xch[tid * 4 + 1];
    *(f32x4*)(part + (size_t)(ks * 4 + 2) * MODN + col) = a2 + xch[tid * 4 + 2]; *(f32x4*)(part + (size_t)(ks * 4 + 3) * MODN + col) = a3 + xch[tid * 4 + 3];
  }
}

template <int MODE>
__device__ __forceinline__ void cvt_wave(const float* src, int ld, int k0, int n0, int nvalid, half_t* dst, int ldd, int drow0, int dstep) {
  const int lane = threadIdx.x & 63, g = lane & 7, nq = lane >> 3;
  f32x4 v[2][8];
  const int n = n0 + 4 * nq;
#pragma unroll
  for (int tl = 0; tl < 2; ++tl)
#pragma unroll
    for (int i = 0; i < 8; ++i) {
      const int kk = 64 * tl + ((MODE == 0) ? (8 * g + i) : (32 * (g >> 2) + 4 * (g & 3) + (i & 3) + 16 * (i >> 2)));
      v[tl][i] = (n < nvalid) ? __builtin_nontemporal_load((const f32x4*)(src + (size_t)(k0 + kk) * ld + n)) : (f32x4){0.f, 0.f, 0.f, 0.f};
    }
#pragma unroll
  for (int tl = 0; tl < 2; ++tl) {
    half8 o0, o1, o2, o3;
#pragma unroll
    for (int i = 0; i < 8; ++i) { o0[i] = (half_t)v[tl][i][0]; o1[i] = (half_t)v[tl][i][1]; o2[i] = (half_t)v[tl][i][2]; o3[i] = (half_t)v[tl][i][3]; }
    half_t* d = dst + (size_t)(drow0 + 4 * nq * dstep) * ldd + k0 + 64 * tl + 8 * g;
    *(half8*)(d) = o0; *(half8*)(d + (size_t)dstep * ldd) = o1; *(half8*)(d + (size_t)2 * dstep * ldd) = o2; *(half8*)(d + (size_t)3 * dstep * ldd) = o3;
  }
}
constexpr int CV_WIN = 432, CV_WOUT = CV_WIN + 128, CV_WUV = CV_WOUT + 16, CV_WUK = CV_WUV + 128, CV_WR = CV_WUK + 32, CV_GU = CV_WR + 2048, CV_DN = CV_GU + 1024;
__device__ void p0_convert(const Params& p, int it) {
  const int tid = threadIdx.x, wid = tid >> 6;
  if (it < CV_WIN) { const int kt = it & 15, nb = it >> 4;
    cvt_wave<0>(p.w_in, IN_COLS, kt * 128, nb * 256 + wid * 32, IN_COLS, (half_t*)(p.ws + WS_WIN16), D, nb * 256 + wid * 32, 1); return; }
  if (it < CV_WOUT) { const int r = it - CV_WIN, kt = r & 15, nb = r >> 4;
    cvt_wave<0>(p.w_out, D, kt * 128, nb * 256 + wid * 32, D, (half_t*)(p.ws + WS_WOUT16), D, nb * 256 + wid * 32, 1); return; }
  if (it < CV_WUV) { const int r = it - CV_WOUT, h = r >> 1, kt = (r & 1) * 2 + (wid >> 2), nt = wid & 3;
    cvt_wave<1>(p.w_uv + (size_t)h * 512 * 128, 128, kt * 128, nt * 32, 128, (half_t*)(p.ws + WS_WUV16) + (size_t)h * 128 * 512, 512, nt * 32, 1); return; }
  if (it < CV_WUK) { const int r = it - CV_WUV; const size_t e0 = (size_t)r * 4096 + tid * 8; const float* s = p.w_uk + e0;
    const float4 a = *(const float4*)s, b = *(const float4*)(s + 4);
    half8 o; o[0] = (half_t)a.x; o[1] = (half_t)a.y; o[2] = (half_t)a.z; o[3] = (half_t)a.w; o[4] = (half_t)b.x; o[5] = (half_t)b.y; o[6] = (half_t)b.z; o[7] = (half_t)b.w;
    *(half8*)((half_t*)(p.ws + WS_WUK16) + e0) = o; return; }
  if (it < CV_WR) { const int r = it - CV_WUK; const int e0 = r * 4096 + tid * 8; const int n = e0 >> 11, k0 = e0 & 2047;
    half8 o;
#pragma unroll
    for (int e = 0; e < 8; ++e) { float v = 0.f; if (n < 4) v = p.w_rg[(k0 + e) * 4 + n]; else if (n < 36) v = p.w_re[(k0 + e) * 32 + (n - 4)]; o[e] = (half_t)v; }
    *(half8*)((half_t*)(p.ws + WS_WR16) + e0) = o; return; }
  if (it < CV_GU) { const int r = it - CV_WR, e = r >> 6, kt = (r >> 2) & 15, which = (r >> 1) & 1, jb = r & 1;
    const float* s = (which ? p.w_up : p.w_gate) + (size_t)e * D * 512; const int j0 = jb * 256 + wid * 32;
    cvt_wave<0>(s, 512, kt * 128, j0, 512, (half_t*)(p.ws + WS_WGU16) + (size_t)e * 1024 * D, D, 2 * j0 + which, 2); return; }
  { const int r = it - CV_GU, e = r >> 5, kt = (r >> 3) & 3, nb = r & 7;
    cvt_wave<0>(p.w_down + (size_t)e * 512 * D, D, kt * 128, nb * 256 + wid * 32, D, (half_t*)(p.ws + WS_WD16) + (size_t)e * D * 512, 512, nb * 256 + wid * 32, 1); }
}
__device__ void phase0(const Params& p, char* lds) {
  for (int it = blockIdx.x; it < 256; it += gridDim.x) p0_modpart(p, lds, it);
  for (int it = blockIdx.x; it < CV_WR; it += gridDim.x) p0_convert(p, it);
}

__device__ __forceinline__ float modsum(const Params& p, int b, int c) {
  const float* part = (const float*)(p.ws + WS_PART);
  float s = (c < 12288) ? p.b_ada[c] : p.b_ada_f[c - 12288];
#pragma unroll
  for (int ks = 0; ks < KSPLIT; ++ks) s += part[(size_t)(ks * 4 + b) * MODN + c];
  return s;
}
__device__ void phase1(const Params& p, char* lds) {
  const int tid = threadIdx.x, lane = tid & 63, wid = tid >> 6;
  float* s1 = (float*)lds; float* sh1 = s1 + D;
  float* modf = (float*)(p.ws + WS_MOD);
  half_t* h16 = (half_t*)(p.ws + WS_H16);
  for (int rg = blockIdx.x; rg < 256; rg += gridDim.x) {
    const int b = rg >> 6;
    if (tid < 256) { const int idx = rg * 256 + tid; modf[idx] = modsum(p, idx >> 14, idx & (MODN - 1)); }
    for (int c = tid; c < D; c += NT) { const float sc = modsum(p, b, D + c), sh = modsum(p, b, c); s1[c] = p.g_mix[c] * (1.0f + sc); sh1[c] = sh; }
    __syncthreads();
    for (int i = 0; i < 4; ++i) {
      const int t = rg * 32 + wid * 4 + i;
      const float* xr = p.x + (size_t)t * D;
      float4 v[4][2]; float ss = 0.f;
#pragma unroll
      for (int j = 0; j < 4; ++j) { const int c = lane * 8 + 512 * j; v[j][0] = *(const float4*)(xr + c); v[j][1] = *(const float4*)(xr + c + 4);
        ss += v[j][0].x * v[j][0].x + v[j][0].y * v[j][0].y + v[j][0].z * v[j][0].z + v[j][0].w * v[j][0].w + v[j][1].x * v[j][1].x + v[j][1].y * v[j][1].y + v[j][1].z * v[j][1].z + v[j][1].w * v[j][1].w; }
      ss = wave_sum(ss);
      const float rstd = rsqrtf(ss * (1.0f / D) + EPS);
#pragma unroll
      for (int j = 0; j < 4; ++j) { const int c = lane * 8 + 512 * j; const float xv[8] = {v[j][0].x, v[j][0].y, v[j][0].z, v[j][0].w, v[j][1].x, v[j][1].y, v[j][1].z, v[j][1].w};
        half8 o;
#pragma unroll
        for (int e = 0; e < 8; ++e) o[e] = (half_t)(xv[e] * rstd * s1[c + e] + sh1[c + e]);
        *(half8*)(h16 + (size_t)t * D + c) = o; }
    }
    __syncthreads();
  }
}

template <class ARow, class Epi>
__device__ __forceinline__ void sg_tile(char* lds, ARow arow, const half_t* Bt, int ldb, int K, Epi epi) {
  const int tid = threadIdx.x, lane = tid & 63, wid = tid >> 6, wr = wid >> 2, wc = wid & 3, fr = lane & 15, fq = lane >> 4;
  half_t* As = (half_t*)lds; half_t* Bs = As + 128 * 72;
  const int lr = tid >> 3, lc = (tid & 7) * 8;
  const half_t* ap0 = arow(lr) + lc; const half_t* ap1 = arow(lr + 64) + lc;
  const half_t* bp0 = Bt + (size_t)lr * ldb + lc; const half_t* bp1 = Bt + (size_t)(lr + 64) * ldb + lc;
  uint4 ra0 = *(const uint4*)ap0, ra1 = *(const uint4*)ap1, rb0 = *(const uint4*)bp0, rb1 = *(const uint4*)bp1;
  f32x4 acc[4][2];
#pragma unroll
  for (int m = 0; m < 4; ++m)
#pragma unroll
    for (int n = 0; n < 2; ++n) acc[m][n] = (f32x4){0.f, 0.f, 0.f, 0.f};
  for (int k0 = 0; k0 < K; k0 += 64) {
    __syncthreads();
    *(uint4*)(As + lr * 72 + lc) = ra0; *(uint4*)(As + (lr + 64) * 72 + lc) = ra1;
    *(uint4*)(Bs + lr * 72 + lc) = rb0; *(uint4*)(Bs + (lr + 64) * 72 + lc) = rb1;
    __syncthreads();
    if (k0 + 64 < K) { ra0 = *(const uint4*)(ap0 + k0 + 64); ra1 = *(const uint4*)(ap1 + k0 + 64); rb0 = *(const uint4*)(bp0 + k0 + 64); rb1 = *(const uint4*)(bp1 + k0 + 64); }
#pragma unroll
    for (int ks = 0; ks < 2; ++ks) {
      half8 a[4], b[2];
#pragma unroll
      for (int m = 0; m < 4; ++m) a[m] = *(const half8*)(As + (wr * 64 + m * 16 + fr) * 72 + ks * 32 + fq * 8);
#pragma unroll
      for (int n = 0; n < 2; ++n) b[n] = *(const half8*)(Bs + (wc * 32 + n * 16 + fr) * 72 + ks * 32 + fq * 8);
#pragma unroll
      for (int m = 0; m < 4; ++m)
#pragma unroll
        for (int n = 0; n < 2; ++n) acc[m][n] = __builtin_amdgcn_mfma_f32_16x16x32_f16(b[n], a[m], acc[m][n], 0, 0, 0);
    }
  }
#pragma unroll
  for (int m = 0; m < 4; ++m)
#pragma unroll
    for (int n = 0; n < 2; ++n) epi(wr * 64 + m * 16 + fr, wc * 32 + n * 16 + fq * 4, acc[m][n]);
  __syncthreads();
}
__device__ __forceinline__ half4 to_half4(f32x4 v) { half4 o; o[0] = (half_t)v[0]; o[1] = (half_t)v[1]; o[2] = (half_t)v[2]; o[3] = (half_t)v[3]; return o; }


namespace g8 {
constexpr int BM = 256, BK = 64, HALF = 128, HTB = HALF * BK * 2, STAGE_BYTES = 8 * HTB, NXCD = 8, WGM = 4;
__device__ __forceinline__ int lds_byte(int r, int c) { const int st = (r >> 4) * 2 + (c >> 5), rr = r & 15, cc = c & 31, ob = rr * 64 + cc * 2; return st * 1024 + (ob ^ (((ob >> 9) & 1) << 5)); }
__device__ __forceinline__ void stage_rc(int b, int& R, int& C) { const int st = b / 1024, sb = b % 1024, swz = sb ^ (((sb >> 9) & 1) << 5); R = (st >> 1) * 16 + swz / 64; C = (st & 1) * 32 + (swz % 64) / 2; }
__device__ __forceinline__ int perm32(int rho) { const int n = rho >> 4, i = rho & 15; return 8 * (i >> 2) + 4 * n + (i & 3); }
struct Unit { int pm, pn; size_t aoff, boff; };
struct DenseOrder {
  int nM, nN, nwg, G, c; size_t tstep;
  __device__ void init(int M, int N, int K, int G_, int c_) { nM = M / BM; nN = N / BM; nwg = nM * nN; G = G_; c = c_; tstep = (size_t)BM * K * 2; }
  __device__ bool next(int i, Unit& u) const {
    const long L = (long)i * G + c; if (L >= nwg) return false;
    int wgid = (int)L; { const int q = nwg / NXCD, r = nwg % NXCD, xcd = wgid % NXCD, off = wgid / NXCD; wgid = (xcd < r ? xcd * (q + 1) : r * (q + 1) + (xcd - r) * q) + off; }
    const int nig = WGM * nN, gid = wgid / nig, fm = gid * WGM, gsz = (nM - fm) < WGM ? (nM - fm) : WGM;
    u.pm = fm + ((wgid % nig) % gsz); u.pn = (wgid % nig) / gsz; u.aoff = (size_t)u.pm * tstep; u.boff = (size_t)u.pn * tstep; return true;
  }
};
template <class Epi, class Sched>
__device__ __forceinline__ void gemm_phase(LAS unsigned char* lds, const half_t* A, const half_t* Bt, const int K, const int lda, const int ldb, const Sched& S, const Epi& E) {
  const int tid = threadIdx.x, wid = __builtin_amdgcn_readfirstlane(tid >> 6), lane = tid & 63, wr = wid >> 2, wc = wid & 3, fr = lane & 15, fq = lane >> 4;
  const int nt = K / BK;
  unsigned voffA[2], voffB[2];
#pragma unroll
  for (int i = 0; i < 2; ++i) { int R, C; stage_rc(tid * 16 + i * 8192, R, C); const int Rb = Epi::PERM ? ((R & ~31) + perm32(R & 31)) : R;
    voffA[i] = (unsigned)(R * lda + C) * 2u; voffB[i] = (unsigned)(Rb * ldb + C) * 2u; }
  const size_t kstep = (size_t)(BK * 2);
  const size_t hstepA = (size_t)HALF * lda * 2, hstepB = (size_t)HALF * ldb * 2;
  const unsigned ldsw = (unsigned)wid * 1024u;
  const int aoff = lds_byte(wr * 64 + fr, fq * 8), boff = lds_byte(wc * 32 + fr, fq * 8);
#define G8_SA(b, h) (((b) * 2 + (h)) * HTB)
#define G8_SB(b, h) ((4 + (b) * 2 + (h)) * HTB)
#define G8_STAGE(bufoff, gbase, voff) do { _Pragma("unroll") for (int _i = 0; _i < 2; ++_i) \
    __builtin_amdgcn_global_load_lds((const unsigned*)((const char*)(gbase) + (voff)[_i]), (LAS unsigned*)(lds + (bufoff) + ldsw + _i * 8192), 16, 0, 0); } while (0)
#define G8_LDA(dst, b, h) do { _Pragma("unroll") for (int m = 0; m < 4; ++m) _Pragma("unroll") for (int k = 0; k < 2; ++k) dst[m][k] = *(const LAS half8*)(lds + G8_SA(b, h) + aoff + m * 2048 + k * 1024); } while (0)
#define G8_LDB(dst, b, h) do { _Pragma("unroll") for (int n = 0; n < 2; ++n) _Pragma("unroll") for (int k = 0; k < 2; ++k) dst[n][k] = *(const LAS half8*)(lds + G8_SB(b, h) + boff + n * 2048 + k * 1024); } while (0)
#define G8_MMA(ai, bj, At, Bt_) do { __builtin_amdgcn_s_setprio(1); _Pragma("unroll") for (int m = 0; m < 4; ++m) _Pragma("unroll") for (int n = 0; n < 2; ++n) _Pragma("unroll") for (int k = 0; k < 2; ++k) \
    acc[ai][bj][m][n] = __builtin_amdgcn_mfma_f32_16x16x32_f16(Bt_[n][k], At[m][k], acc[ai][bj][m][n], 0, 0, 0); __builtin_amdgcn_s_setprio(0); } while (0)
#define G8_WAIT_V(n) asm volatile("s_waitcnt vmcnt(" #n ")" ::: "memory")
#define G8_WAIT_L(n) asm volatile("s_waitcnt lgkmcnt(" #n ")" ::: "memory")
#define G8_BAR __builtin_amdgcn_s_barrier()
#define G8_SCHED __builtin_amdgcn_sched_barrier(0)
  Unit cur, nxt; int ui = 0;
  if (!S.next(0, cur)) return;
  f32x4 acc[2][2][4][2];
#pragma unroll
  for (int a = 0; a < 2; ++a)
#pragma unroll
    for (int b = 0; b < 2; ++b)
#pragma unroll
      for (int m = 0; m < 4; ++m)
#pragma unroll
        for (int n = 0; n < 2; ++n) acc[a][b][m][n] = (f32x4){0.f, 0.f, 0.f, 0.f};
  half8 At[4][2], B0[2][2], B1[2][2];
  const char* cA = (const char*)A + cur.aoff; const char* cB = (const char*)Bt + cur.boff;
  G8_STAGE(G8_SB(0, 0), cB, voffB); G8_STAGE(G8_SA(0, 0), cA, voffA); G8_STAGE(G8_SB(0, 1), cB + hstepB, voffB); G8_STAGE(G8_SA(0, 1), cA + hstepA, voffA);
  if (wr == 1) G8_BAR;
  G8_WAIT_V(4); G8_BAR;
  G8_STAGE(G8_SB(1, 0), cB + kstep, voffB); G8_STAGE(G8_SA(1, 0), cA + kstep, voffA); G8_STAGE(G8_SB(1, 1), cB + hstepB + kstep, voffB);
  G8_WAIT_V(6); G8_BAR;
  for (;;) {
    const bool has_next = S.next(ui + 1, nxt);
    const char* nA = has_next ? (const char*)A + nxt.aoff : cA; const char* nB = has_next ? (const char*)Bt + nxt.boff : cB;
    for (int t = 0; t < nt; t += 2) {
      const bool last = (t == nt - 2);
      const char* a1 = cA + (size_t)(t + 1) * kstep;
      const char* a2 = last ? nA : cA + (size_t)(t + 2) * kstep; const char* b2 = last ? nB : cB + (size_t)(t + 2) * kstep;
      const char* a3 = a2 + kstep; const char* b3 = b2 + kstep;
      G8_LDB(B0, 0, 0); G8_SCHED; G8_LDA(At, 0, 0); G8_STAGE(G8_SA(1, 1), a1 + hstepA, voffA);
      G8_WAIT_L(8); G8_BAR; G8_WAIT_L(0); G8_MMA(0, 0, At, B0); G8_BAR; G8_SCHED;
      G8_LDB(B1, 0, 1); G8_STAGE(G8_SB(0, 0), b2, voffB);
      G8_BAR; G8_WAIT_L(0); G8_MMA(0, 1, At, B1); G8_BAR;
      G8_LDA(At, 0, 1); G8_STAGE(G8_SA(0, 0), a2, voffA);
      G8_BAR; G8_WAIT_L(0); G8_MMA(1, 0, At, B0); G8_BAR; G8_SCHED;
      G8_STAGE(G8_SB(0, 1), b2 + hstepB, voffB);
      G8_WAIT_V(6); G8_BAR; G8_MMA(1, 1, At, B1); G8_BAR;
      G8_LDB(B0, 1, 0); G8_SCHED; G8_LDA(At, 1, 0); G8_STAGE(G8_SA(0, 1), a2 + hstepA, voffA);
      G8_WAIT_L(8); G8_BAR; G8_WAIT_L(0); G8_MMA(0, 0, At, B0); G8_BAR; G8_SCHED;
      G8_LDB(B1, 1, 1); G8_STAGE(G8_SB(1, 0), b3, voffB);
      G8_BAR; G8_WAIT_L(0); G8_MMA(0, 1, At, B1); G8_BAR;
      G8_LDA(At, 1, 1); G8_STAGE(G8_SA(1, 0), a3, voffA);
      G8_BAR; G8_WAIT_L(0); G8_MMA(1, 0, At, B0); G8_BAR; G8_SCHED;
      G8_STAGE(G8_SB(1, 1), b3 + hstepB, voffB);
      G8_WAIT_V(6); G8_BAR; G8_MMA(1, 1, At, B1); G8_BAR;
    }
    E(acc, cur, wr, wc, fr, fq);
    if (!has_next) break;
#pragma unroll
    for (int a = 0; a < 2; ++a)
#pragma unroll
      for (int b = 0; b < 2; ++b)
#pragma unroll
        for (int m = 0; m < 4; ++m)
#pragma unroll
          for (int n = 0; n < 2; ++n) acc[a][b][m][n] = (f32x4){0.f, 0.f, 0.f, 0.f};
    cur = nxt; cA = nA; cB = nB; ++ui;
  }
  G8_WAIT_V(0);
  if (wr == 0) G8_BAR;
  G8_BAR;
#undef G8_SA
#undef G8_SB
#undef G8_STAGE
#undef G8_LDA
#undef G8_LDB
#undef G8_MMA
#undef G8_WAIT_V
#undef G8_WAIT_L
#undef G8_BAR
#undef G8_SCHED
}
__device__ __forceinline__ half8 pack8(f32x4 a, f32x4 b) { half8 o; o[0] = (half_t)a[0]; o[1] = (half_t)a[1]; o[2] = (half_t)a[2]; o[3] = (half_t)a[3]; o[4] = (half_t)b[0]; o[5] = (half_t)b[1]; o[6] = (half_t)b[2]; o[7] = (half_t)b[3]; return o; }
struct EpiHalf {
  static constexpr bool PERM = true;
  half_t* O; int ldc;
  __device__ __forceinline__ void operator()(const f32x4 (&acc)[2][2][4][2], const Unit& u, int wr, int wc, int fr, int fq) const {
    const int row0 = u.pm * BM + wr * 64 + fr, col0 = u.pn * BM + wc * 32 + 8 * fq;
#pragma unroll
    for (int ai = 0; ai < 2; ++ai)
#pragma unroll
      for (int m = 0; m < 4; ++m) { half_t* rowp = O + (size_t)(row0 + ai * HALF + m * 16) * ldc + col0;
#pragma unroll
        for (int bj = 0; bj < 2; ++bj) *(half8*)(rowp + bj * HALF) = pack8(acc[ai][bj][m][0], acc[ai][bj][m][1]); }
  }
};
struct EpiQlat {
  static constexpr bool PERM = true;
  half_t* O;
  __device__ __forceinline__ void operator()(const f32x4 (&acc)[2][2][4][2], const Unit& u, int wr, int wc, int fr, int fq) const {
    const int row0 = u.pm * BM + wr * 64 + fr, col0 = u.pn * BM + wc * 32 + 8 * fq;
#pragma unroll
    for (int ai = 0; ai < 2; ++ai)
#pragma unroll
      for (int m = 0; m < 4; ++m) { half_t* rowp = O + (size_t)(row0 + ai * HALF + m * 16) * 4096 + col0;
#pragma unroll
        for (int bj = 0; bj < 2; ++bj) *(half8*)(rowp + bj * HALF) = pack8(acc[ai][bj][m][0] * QSCALE, acc[ai][bj][m][1] * QSCALE); }
  }
};
struct EpiResid {
  static constexpr bool PERM = true;
  const float* x; const float* modf; half_t* x1;
  __device__ __forceinline__ void operator()(const f32x4 (&acc)[2][2][4][2], const Unit& u, int wr, int wc, int fr, int fq) const {
    const int row0 = u.pm * BM + wr * 64 + fr, col0 = u.pn * BM + wc * 32 + 8 * fq;
#pragma unroll
    for (int ai = 0; ai < 2; ++ai)
#pragma unroll
      for (int m = 0; m < 4; ++m) { const int t = row0 + ai * HALF + m * 16, b = t >> 11;
#pragma unroll
        for (int bj = 0; bj < 2; ++bj) { const int c = col0 + bj * HALF;
          const f32x4 xa = *(const f32x4*)(x + (size_t)t * D + c), xb = *(const f32x4*)(x + (size_t)t * D + c + 4);
          const f32x4 ga = *(const f32x4*)(modf + b * MODN + 4096 + c), gb = *(const f32x4*)(modf + b * MODN + 4096 + c + 4);
          *(half8*)(x1 + (size_t)t * D + c) = pack8(xa + ga * acc[ai][bj][m][0], xb + gb * acc[ai][bj][m][1]); } }
  }
};
struct EpiMoe1 {
  static constexpr bool PERM = true;
  half_t* act; const float* cslot;
  __device__ __forceinline__ void operator()(const f32x4 (&acc)[2][2][4][2], const Unit& u, int wr, int wc, int fr, int fq) const {
    const int row0 = u.pm * BM + wr * 64 + fr, col0 = u.pn * BM + wc * 32 + 8 * fq;
#pragma unroll
    for (int ai = 0; ai < 2; ++ai)
#pragma unroll
      for (int m = 0; m < 4; ++m) { const int slot = row0 + ai * HALF + m * 16; const float cw = cslot[slot];
#pragma unroll
        for (int bj = 0; bj < 2; ++bj) { const f32x4 v0 = acc[ai][bj][m][0], v1 = acc[ai][bj][m][1]; half4 o;
          o[0] = (half_t)(v0[0] / (1.0f + __expf(-v0[0])) * v0[1] * cw); o[1] = (half_t)(v0[2] / (1.0f + __expf(-v0[2])) * v0[3] * cw);
          o[2] = (half_t)(v1[0] / (1.0f + __expf(-v1[0])) * v1[1] * cw); o[3] = (half_t)(v1[2] / (1.0f + __expf(-v1[2])) * v1[3] * cw);
          *(half4*)(act + (size_t)slot * 512 + ((col0 + bj * HALF) >> 1)) = o; } }
  }
};
struct EpiMoe2 {
  static constexpr bool PERM = true;
  half_t* out2; const int* rowmap;
  __device__ __forceinline__ void operator()(const f32x4 (&acc)[2][2][4][2], const Unit& u, int wr, int wc, int fr, int fq) const {
    const int row0 = u.pm * BM + wr * 64 + fr, col0 = u.pn * BM + wc * 32 + 8 * fq;
#pragma unroll
    for (int ai = 0; ai < 2; ++ai)
#pragma unroll
      for (int m = 0; m < 4; ++m) { const int rm = rowmap[row0 + ai * HALF + m * 16];
        if (rm >= 0) { half_t* rowp = out2 + (size_t)rm * D + col0;
#pragma unroll
          for (int bj = 0; bj < 2; ++bj) *(half8*)(rowp + bj * HALF) = pack8(acc[ai][bj][m][0], acc[ai][bj][m][1]); } }
  }
};
}

__device__ void phase2(const Params& p, char* lds) {
  g8::DenseOrder S; S.init(NTOK, NPAD, D, gridDim.x, blockIdx.x);
  g8::EpiHalf E{(half_t*)(p.ws + WS_PROJ16), NPAD};
  g8::gemm_phase(( LAS unsigned char*)lds, (const half_t*)(p.ws + WS_H16), (const half_t*)(p.ws + WS_WIN16), D, D, D, S, E);
}

__device__ void index_block(const Params& p, char* lds, int b, int tb) {
  const int tid = threadIdx.x, lane = tid & 63, wid = tid >> 6;
  const half_t* proj = (const half_t*)(p.ws + WS_PROJ16);
  float* score = (float*)(p.ws + WS_SCORE);
  half_t* Bs = (half_t*)lds;
  const int t0 = b * SEQ + tb * 16;
  const int r = lane & 31, tokb = (r >> 2) & 1, head = (r & 3) + 4 * (r >> 3), kb = lane >> 5;
  half8 af[8];
  { const half_t* src = proj + (size_t)(t0 + 2 * wid + tokb) * NPAD + OFF_IQ + head * 128 + kb * 8;
#pragma unroll
    for (int ks = 0; ks < 8; ++ks) af[ks] = *(const half8*)(src + ks * 16); }
  float wgt[16];
  { const half_t* ws = proj + (size_t)(t0 + 2 * wid + kb) * NPAD + OFF_IW; const half8 w0 = *(const half8*)ws, w1 = *(const half8*)(ws + 8);
#pragma unroll
    for (int e = 0; e < 8; ++e) { wgt[e] = (float)w0[e] * IWSCALE; wgt[8 + e] = (float)w1[e] * IWSCALE; } }
  const int nkt = (tb * 16 + 15) / 128 + 1;
  const int lrow = tid >> 4, lc = (tid & 15) * 8;
  const half_t* bsrc = proj + (size_t)(b * SEQ + lrow) * NPAD + OFF_IK + lc;
  u32x4 rb[4];
#pragma unroll
  for (int i = 0; i < 4; ++i) rb[i] = *(const u32x4*)(bsrc + (size_t)(32 * i) * NPAD);
  LDS_BARRIER();
#pragma unroll
  for (int i = 0; i < 4; ++i) *(u32x4*)(Bs + (lrow + 32 * i) * 136 + lc) = rb[i];
  LDS_BARRIER();
  for (int kt = 0; kt < nkt; ++kt) {
    if (kt + 1 < nkt) {
#pragma unroll
      for (int i = 0; i < 4; ++i) rb[i] = *(const u32x4*)(bsrc + (size_t)((kt + 1) * 128 + 32 * i) * NPAD);
    }
    const half_t* bt = Bs + (kt & 1) * (128 * 136);
#pragma unroll
    for (int sub = 0; sub < 4; ++sub) {
      f32x16 acc;
#pragma unroll
      for (int i = 0; i < 16; ++i) acc[i] = 0.f;
#pragma unroll
      for (int ks = 0; ks < 8; ++ks) { const half8 bf = *(const half8*)(bt + (sub * 32 + (lane & 31)) * 136 + ks * 16 + kb * 8); acc = __builtin_amdgcn_mfma_f32_32x32x16_f16(af[ks], bf, acc, 0, 0, 0); }
      float s = 0.f;
#pragma unroll
      for (int i = 0; i < 16; ++i) s += fmaxf(acc[i], 0.f) * wgt[i];
      score[(size_t)(t0 + 2 * wid + kb) * SEQ + kt * 128 + sub * 32 + (lane & 31)] = s;
    }
    if (kt + 1 < nkt) {
#pragma unroll
      for (int i = 0; i < 4; ++i) *(u32x4*)(Bs + ((kt + 1) & 1) * (128 * 136) + (lrow + 32 * i) * 136 + lc) = rb[i];
    }
    LDS_BARRIER();
  }
}
__device__ __forceinline__ unsigned sortable(float f) { const unsigned u = __float_as_uint(f); return (u & 0x80000000u) ? ~u : (u | 0x80000000u); }
template <int JN> __device__ __forceinline__ int wave_count_ge(const float (&s)[JN], float cand) {
  int cnt = 0;
#pragma unroll
  for (int j = 0; j < JN; ++j) cnt += (s[j] >= cand) ? 1 : 0;
  int tot = 0;
#pragma unroll
  for (int b = 0; b < 6; ++b) tot += __popcll(__ballot((cnt >> b) & 1)) << b;
  return tot;
}
template <int JN> __device__ __forceinline__ void topk_search(const float* sc, unsigned* mask, int pos) {
  const int lane = threadIdx.x & 63, n = pos + 1;
  float s[JN];
#pragma unroll
  for (int j = 0; j < JN; ++j) { const int idx = lane + 64 * j; const float v = __hip_atomic_load(sc + idx, __ATOMIC_RELAXED, __HIP_MEMORY_SCOPE_AGENT); s[j] = (idx <= pos) ? v : -INFINITY; }
  float vmax = -INFINITY, vmin = INFINITY;
#pragma unroll
  for (int j = 0; j < JN; ++j) { vmax = fmaxf(vmax, s[j]); vmin = fminf(vmin, (s[j] == -INFINITY) ? INFINITY : s[j]); }
  vmax = wave_max(vmax); vmin = -wave_max(-vmin);
  float lo = vmin, hi = vmax, thr = 0.f; int cl = n, ch = wave_count_ge<JN>(s, hi); bool found = false;
  if (ch == 256) { found = true; thr = hi; }
  else if (ch < 256) {
    for (int it = 0; it < 80; ++it) {
      float cand = (it < 14) ? (hi - (hi - lo) * ((float)(256 - ch) / (float)(cl - ch))) : 0.5f * (lo + hi);
      if (!(cand > lo && cand < hi)) cand = 0.5f * (lo + hi);
      if (!(cand > lo && cand < hi)) break;
      const int c = wave_count_ge<JN>(s, cand);
      if (c == 256) { found = true; thr = cand; break; }
      if (c > 256) { lo = cand; cl = c; } else { hi = cand; ch = c; }
    }
  }
  const float tv = found ? thr : lo; const int need = found ? 4096 : (256 - ch);
  unsigned long long mine = 0ull; int eqseen = 0;
  const unsigned long long ltmask = (1ull << lane) - 1ull;
#pragma unroll
  for (int j = 0; j < JN; ++j) {
    const bool gt = s[j] > tv, eq = s[j] == tv;
    const unsigned long long meq = __ballot(eq);
    const bool take = gt || (eq && (eqseen + __popcll(meq & ltmask)) < need);
    const unsigned long long ms = __ballot(take);
    if (lane == j) mine = ms;
    eqseen += __popcll(meq);
  }
  if (lane < 32) *(unsigned long long*)(mask + 2 * lane) = mine;
}
__device__ void topk_token(const Params& p, int t, int pos) {
  const int lane = threadIdx.x & 63;
  unsigned* mask = (unsigned*)(p.ws + WS_MASK) + (size_t)t * 64;
  const int n = pos + 1;
  if (n <= 256) {
    const int lo = 32 * lane;
    mask[lane] = (n >= lo + 32) ? 0xFFFFFFFFu : (n > lo ? ((1u << (n - lo)) - 1u) : 0u);
    return;
  }
  const float* sc = (const float*)(p.ws + WS_SCORE) + (size_t)t * SEQ;
  if (pos < 1024) topk_search<16>(sc, mask, pos); else topk_search<32>(sc, mask, pos);
}
__device__ void p3_rows(const Params& p, int t) {
  const int lane = threadIdx.x & 63;
  const half_t* proj = (const half_t*)(p.ws + WS_PROJ16);
  const half_t* pr = proj + (size_t)t * NPAD;
  {
    const half8 v = *(const half8*)(pr + OFF_KV + lane * 8);
    float f[8], ss = 0.f;
#pragma unroll
    for (int e = 0; e < 8; ++e) { f[e] = (float)v[e]; ss += f[e] * f[e]; }
    ss = wave_sum(ss);
    const float rstd = rsqrtf(ss * (1.0f / 512.f) + EPS);
    half8 o;
#pragma unroll
    for (int e = 0; e < 8; ++e) o[e] = (half_t)(f[e] * rstd * p.kv_norm_g[lane * 8 + e]);
    *(half8*)((half_t*)(p.ws + WS_CKV16) + (size_t)t * 512 + lane * 8) = o;
  }
  {
    const int pos = t & (SEQ - 1);
    float y[16], ss = 0.f;
#pragma unroll
    for (int hb = 0; hb < 2; ++hb) {
      const int c = lane * 8 + 512 * hb;
      const half8 bg = *(const half8*)(pr + OFF_B + c);
      const half8 c0 = *(const half8*)(pr + OFF_C + c), x0 = *(const half8*)(pr + OFF_X + c);
      half8 c1 = c0, x1 = x0, c2 = c0, x2 = x0;
      if (pos >= 1) { c1 = *(const half8*)(pr - NPAD + OFF_C + c); x1 = *(const half8*)(pr - NPAD + OFF_X + c); }
      if (pos >= 2) { c2 = *(const half8*)(pr - 2 * NPAD + OFF_C + c); x2 = *(const half8*)(pr - 2 * NPAD + OFF_X + c); }
#pragma unroll
      for (int e = 0; e < 8; ++e) {
        const float u0 = (float)c0[e] * (float)x0[e];
        const float u1 = pos >= 1 ? (float)c1[e] * (float)x1[e] : 0.f;
        const float u2 = pos >= 2 ? (float)c2[e] * (float)x2[e] : 0.f;
        const float cv = p.conv_w[c + e] * u2 + p.conv_w[1024 + c + e] * u1 + p.conv_w[2048 + c + e] * u0;
        const float yy = (float)bg[e] * cv; y[hb * 8 + e] = yy; ss += yy * yy;
      }
    }
    ss = wave_sum(ss);
    const float rstd = rsqrtf(ss * (1.0f / 1024.f) + EPS);
    half_t* mix = (half_t*)(p.ws + WS_MIX16) + (size_t)t * D;
#pragma unroll
    for (int hb = 0; hb < 2; ++hb) { const int c = lane * 8 + 512 * hb; half8 o;
#pragma unroll
      for (int e = 0; e < 8; ++e) o[e] = (half_t)(y[hb * 8 + e] * rstd * p.g_conv_out[c + e]);
      *(half8*)(mix + c) = o; }
  }
}
struct QlatOrder {
  int G, c;
  __device__ bool next(int i, g8::Unit& u) const {
    const int L = i * G + c; if (L >= 512) return false;
    const int pm = L >> 4, pn = L & 15, h = pn >> 1;
    u.pm = pm; u.pn = pn; u.aoff = ((size_t)pm * 256 * NPAD + OFF_Q + h * 128) * 2; u.boff = (size_t)pn * 256 * 128 * 2; return true;
  }
};
__device__ void phase3(const Params& p, char* lds) {
  const int wid = threadIdx.x >> 6, sub = p.sub;
  if (sub == 0 || sub == 1)
  for (int it = blockIdx.x; it < 256; it += gridDim.x) {
    const int b = it >> 6, jp = it & 63;
    for (int half = 0; half < 2; ++half) {
      const int tb = half ? (127 - jp) : jp;
      index_block(p, lds, b, tb);
      __syncthreads();
      for (int hh = 0; hh < 2; ++hh) topk_token(p, b * SEQ + tb * 16 + 2 * wid + hh, tb * 16 + 2 * wid + hh);
      __syncthreads();
    }
  }
  if (sub == 0 || sub == 2)
  {
    QlatOrder S{(int)gridDim.x, (int)blockIdx.x};
    g8::EpiQlat E{(half_t*)(p.ws + WS_QLAT16)};
    __syncthreads();
    g8::gemm_phase((LAS unsigned char*)lds, (const half_t*)(p.ws + WS_PROJ16), (const half_t*)(p.ws + WS_WUK16), 128, NPAD, 128, S, E);
  }
  if (sub == 0 || sub == 3)
  for (int t = blockIdx.x * 8 + wid; t < NTOK; t += gridDim.x * 8) p3_rows(p, t);
}

__device__ __forceinline__ float quad_max(float x) {
  auto r = __builtin_amdgcn_permlane16_swap(__float_as_uint(x), __float_as_uint(x), false, false); x = fmaxf(__uint_as_float(r[0]), __uint_as_float(r[1]));
  auto q = __builtin_amdgcn_permlane32_swap(__float_as_uint(x), __float_as_uint(x), false, false); return fmaxf(__uint_as_float(q[0]), __uint_as_float(q[1])); }
__device__ __forceinline__ float quad_sum(float x) {
  auto r = __builtin_amdgcn_permlane16_swap(__float_as_uint(x), __float_as_uint(x), false, false); x = __uint_as_float(r[0]) + __uint_as_float(r[1]);
  auto q = __builtin_amdgcn_permlane32_swap(__float_as_uint(x), __float_as_uint(x), false, false); return __uint_as_float(q[0]) + __uint_as_float(q[1]); }
__device__ __forceinline__ half8 pack8h(f32x4 a, f32x4 b) { half8 o; o[0] = (half_t)a[0]; o[1] = (half_t)a[1]; o[2] = (half_t)a[2]; o[3] = (half_t)a[3]; o[4] = (half_t)b[0]; o[5] = (half_t)b[1]; o[6] = (half_t)b[2]; o[7] = (half_t)b[3]; return o; }
template <int OFF> __device__ __forceinline__ half4 tr_read(unsigned addr) { half4 r; asm volatile("ds_read_b64_tr_b16 %0, %1 offset:%2" : "=&v"(r) : "v"(addr), "i"(OFF) : "memory"); return r; }
__device__ __forceinline__ void attn_dma_tile(LAS char* L, const half_t* kvb, int kt, int buf, int wid, int lane) {
  const unsigned v0 = (((wid & 1) * 16 + (lane >> 4)) * 1024u) + (wid >> 1) * 256u + 16u * ((lane & 15) ^ ((lane >> 4) << 1));
  const char* tb = (const char*)(kvb + (size_t)kt * 32 * 512);
#pragma unroll
  for (int i = 0; i < 4; ++i)
    __builtin_amdgcn_global_load_lds((const unsigned*)(tb + ((v0 + i * 4096u) ^ (128u * (i & 1)))), (LAS unsigned*)(L + buf * 32768 + (wid * 4 + i) * 1024), 16, 0, 0);
}
template <int STAGE> __device__ __forceinline__ void attn_task(const Params& p, char* lds, int b, int tb, int tb_prev) {
  const int tid = threadIdx.x, lane = tid & 63, wid = __builtin_amdgcn_readfirstlane(tid >> 6), fr = lane & 15, fq = lane >> 4;
  LAS char* L = (LAS char*)lds;
  LAS unsigned* maskl = (LAS unsigned*)(L + 65536);
  const int t0 = b * SEQ + tb * 16;
  const int nkt = ((tb * 16 + 15) >> 5) + 1;
  const half_t* kvb = (const half_t*)(p.ws + WS_CKV16) + (size_t)b * SEQ * 512;
  __syncthreads();
  { const unsigned* mg = (const unsigned*)(p.ws + WS_MASK) + (size_t)t0 * 64; maskl[tid] = mg[tid]; maskl[tid + 512] = mg[tid + 512]; }
  half8 qf[6];
  LAS char* Lq = L + 73728 + wid * 10240 + lane * 16;
  { const half_t* qs = (const half_t*)(p.ws + WS_QLAT16) + (size_t)(t0 + fr) * 4096 + wid * 512 + fq * 8;
#pragma unroll
    for (int s = 0; s < 6; ++s) qf[s] = *(const half8*)(qs + 32 * s);
#pragma unroll
    for (int s = 6; s < 16; ++s) *(LAS half8*)(Lq + (s - 6) * 1024) = *(const half8*)(qs + 32 * s); }
  const unsigned R2 = 256u * fr + ((16u * fq) ^ ((fr & 7u) << 5));
  const unsigned q4 = (lane & 15) >> 2, pp = lane & 3, rowt = 4 * fq + q4;
  const unsigned Rt = (unsigned)(size_t)L + 256u * rowt + ((rowt & 7u) << 5) + 16u * (pp >> 1) + 8u * (pp & 1);
  f32x4 o[32];
#pragma unroll
  for (int n = 0; n < 32; ++n) o[n] = (f32x4){0.f, 0.f, 0.f, 0.f};
  float m = -1e30f, l = 0.f;
  attn_dma_tile(L, kvb, 0, 0, wid, lane);
  asm volatile("s_waitcnt vmcnt(0)" ::: "memory");
  __syncthreads();
  for (int kt = 0; kt < nkt; ++kt) {
    if (kt + 1 < nkt) attn_dma_tile(L, kvb, kt + 1, (kt + 1) & 1, wid, lane);
    const unsigned bo = (kt & 1) * 32768u;
    f32x4 s0 = (f32x4){0.f, 0.f, 0.f, 0.f}, s1 = (f32x4){0.f, 0.f, 0.f, 0.f};
#pragma unroll
    for (int g = 0; g < 4; ++g) {
      half8 ka[4], kb[4], qv[4];
#pragma unroll
      for (int i = 0; i < 4; ++i) { const int s = 4 * g + i; const unsigned ra = (R2 + bo) ^ (64u * i);
        ka[i] = *(const LAS half8*)(L + ra + g * 8192); kb[i] = *(const LAS half8*)(L + ra + g * 8192 + 4096);
        qv[i] = (s < 6) ? qf[s < 6 ? s : 0] : *(const LAS half8*)(Lq + (s - 6) * 1024); }
      __builtin_amdgcn_sched_barrier(0);
#pragma unroll
      for (int i = 0; i < 4; ++i) { s0 = __builtin_amdgcn_mfma_f32_16x16x32_f16(ka[i], qv[i], s0, 0, 0, 0); s1 = __builtin_amdgcn_mfma_f32_16x16x32_f16(kb[i], qv[i], s1, 0, 0, 0); }
      __builtin_amdgcn_sched_barrier(0);
    }
    const unsigned mw = maskl[fr * 64 + kt] >> (4 * fq);
    float sv[8];
#pragma unroll
    for (int r = 0; r < 4; ++r) { sv[r] = ((mw >> r) & 1u) ? s0[r] : -INFINITY; sv[4 + r] = ((mw >> (16 + r)) & 1u) ? s1[r] : -INFINITY; }
    float mt = fmaxf(fmaxf(fmaxf(sv[0], sv[1]), fmaxf(sv[2], sv[3])), fmaxf(fmaxf(sv[4], sv[5]), fmaxf(sv[6], sv[7])));
    mt = quad_max(mt);
    if (__any(mt > m + 8.0f)) {
      const float mn = fmaxf(m, mt), sc = __builtin_amdgcn_exp2f(m - mn);
      l *= sc; m = mn;
#pragma unroll
      for (int n = 0; n < 32; ++n) o[n] *= sc;
    }
    half8 pf; float ps = 0.f;
#pragma unroll
    for (int r = 0; r < 8; ++r) { const float pv = __builtin_amdgcn_exp2f(sv[r] - m); ps += pv; pf[r] = (half_t)pv; }
    l += ps;
asm volatile("s_waitcnt lgkmcnt(0)" ::: "memory"); __builtin_amdgcn_sched_barrier(0);
    const half4 xa0 = tr_read<0>((Rt + bo) ^ 0u), ya0 = tr_read<4096>((Rt + bo) ^ 0u), xb0 = tr_read<0>((Rt + bo) ^ 32u), yb0 = tr_read<4096>((Rt + bo) ^ 32u);
    const half4 xa1 = tr_read<0>((Rt + bo) ^ 64u), ya1 = tr_read<4096>((Rt + bo) ^ 64u), xb1 = tr_read<0>((Rt + bo) ^ 96u), yb1 = tr_read<4096>((Rt + bo) ^ 96u);
    asm volatile("s_waitcnt lgkmcnt(4)" ::: "memory"); __builtin_amdgcn_sched_barrier(0);
    o[0] = __builtin_amdgcn_mfma_f32_16x16x32_f16((half8){xa0[0], xa0[1], xa0[2], xa0[3], ya0[0], ya0[1], ya0[2], ya0[3]}, pf, o[0], 0, 0, 0);
    o[1] = __builtin_amdgcn_mfma_f32_16x16x32_f16((half8){xb0[0], xb0[1], xb0[2], xb0[3], yb0[0], yb0[1], yb0[2], yb0[3]}, pf, o[1], 0, 0, 0);
    __builtin_amdgcn_sched_barrier(0);
    const half4 xa2 = tr_read<0>((Rt + bo) ^ 128u), ya2 = tr_read<4096>((Rt + bo) ^ 128u), xb2 = tr_read<0>((Rt + bo) ^ 160u), yb2 = tr_read<4096>((Rt + bo) ^ 160u);
    asm volatile("s_waitcnt lgkmcnt(4)" ::: "memory"); __builtin_amdgcn_sched_barrier(0);
    o[2] = __builtin_amdgcn_mfma_f32_16x16x32_f16((half8){xa1[0], xa1[1], xa1[2], xa1[3], ya1[0], ya1[1], ya1[2], ya1[3]}, pf, o[2], 0, 0, 0);
    o[3] = __builtin_amdgcn_mfma_f32_16x16x32_f16((half8){xb1[0], xb1[1], xb1[2], xb1[3], yb1[0], yb1[1], yb1[2], yb1[3]}, pf, o[3], 0, 0, 0);
    __builtin_amdgcn_sched_barrier(0);
    const half4 xa3 = tr_read<0>((Rt + bo) ^ 192u), ya3 = tr_read<4096>((Rt + bo) ^ 192u), xb3 = tr_read<0>((Rt + bo) ^ 224u), yb3 = tr_read<4096>((Rt + bo) ^ 224u);
    asm volatile("s_waitcnt lgkmcnt(4)" ::: "memory"); __builtin_amdgcn_sched_barrier(0);
    o[4] = __builtin_amdgcn_mfma_f32_16x16x32_f16((half8){xa2[0], xa2[1], xa2[2], xa2[3], ya2[0], ya2[1], ya2[2], ya2[3]}, pf, o[4], 0, 0, 0);
    o[5] = __builtin_amdgcn_mfma_f32_16x16x32_f16((half8){xb2[0], xb2[1], xb2[2], xb2[3], yb2[0], yb2[1], yb2[2], yb2[3]}, pf, o[5], 0, 0, 0);
    __builtin_amdgcn_sched_barrier(0);
    const half4 xa4 = tr_read<8192>((Rt + bo) ^ 0u), ya4 = tr_read<12288>((Rt + bo) ^ 0u), xb4 = tr_read<8192>((Rt + bo) ^ 32u), yb4 = tr_read<12288>((Rt + bo) ^ 32u);
    asm volatile("s_waitcnt lgkmcnt(4)" ::: "memory"); __builtin_amdgcn_sched_barrier(0);
    o[6] = __builtin_amdgcn_mfma_f32_16x16x32_f16((half8){xa3[0], xa3[1], xa3[2], xa3[3], ya3[0], ya3[1], ya3[2], ya3[3]}, pf, o[6], 0, 0, 0);
    o[7] = __builtin_amdgcn_mfma_f32_16x16x32_f16((half8){xb3[0], xb3[1], xb3[2], xb3[3], yb3[0], yb3[1], yb3[2], yb3[3]}, pf, o[7], 0, 0, 0);
    __builtin_amdgcn_sched_barrier(0);
    const half4 xa5 = tr_read<8192>((Rt + bo) ^ 64u), ya5 = tr_read<12288>((Rt + bo) ^ 64u), xb5 = tr_read<8192>((Rt + bo) ^ 96u), yb5 = tr_read<12288>((Rt + bo) ^ 96u);
    asm volatile("s_waitcnt lgkmcnt(4)" ::: "memory"); __builtin_amdgcn_sched_barrier(0);
    o[8] = __builtin_amdgcn_mfma_f32_16x16x32_f16((half8){xa4[0], xa4[1], xa4[2], xa4[3], ya4[0], ya4[1], ya4[2], ya4[3]}, pf, o[8], 0, 0, 0);
    o[9] = __builtin_amdgcn_mfma_f32_16x16x32_f16((half8){xb4[0], xb4[1], xb4[2], xb4[3], yb4[0], yb4[1], yb4[2], yb4[3]}, pf, o[9], 0, 0, 0);
    __builtin_amdgcn_sched_barrier(0);
    const half4 xa6 = tr_read<8192>((Rt + bo) ^ 128u), ya6 = tr_read<12288>((Rt + bo) ^ 128u), xb6 = tr_read<8192>((Rt + bo) ^ 160u), yb6 = tr_read<12288>((Rt + bo) ^ 160u);
    asm volatile("s_waitcnt lgkmcnt(4)" ::: "memory"); __builtin_amdgcn_sched_barrier(0);
    o[10] = __builtin_amdgcn_mfma_f32_16x16x32_f16((half8){xa5[0], xa5[1], xa5[2], xa5[3], ya5[0], ya5[1], ya5[2], ya5[3]}, pf, o[10], 0, 0, 0);
    o[11] = __builtin_amdgcn_mfma_f32_16x16x32_f16((half8){xb5[0], xb5[1], xb5[2], xb5[3], yb5[0], yb5[1], yb5[2], yb5[3]}, pf, o[11], 0, 0, 0);
    __builtin_amdgcn_sched_barrier(0);
    const half4 xa7 = tr_read<8192>((Rt + bo) ^ 192u), ya7 = tr_read<12288>((Rt + bo) ^ 192u), xb7 = tr_read<8192>((Rt + bo) ^ 224u), yb7 = tr_read<12288>((Rt + bo) ^ 224u);
    asm volatile("s_waitcnt lgkmcnt(4)" ::: "memory"); __builtin_amdgcn_sched_barrier(0);
    o[12] = __builtin_amdgcn_mfma_f32_16x16x32_f16((half8){xa6[0], xa6[1], xa6[2], xa6[3], ya6[0], ya6[1], ya6[2], ya6[3]}, pf, o[12], 0, 0, 0);
    o[13] = __builtin_amdgcn_mfma_f32_16x16x32_f16((half8){xb6[0], xb6[1], xb6[2], xb6[3], yb6[0], yb6[1], yb6[2], yb6[3]}, pf, o[13], 0, 0, 0);
    __builtin_amdgcn_sched_barrier(0);
    const half4 xa8 = tr_read<16384>((Rt + bo) ^ 0u), ya8 = tr_read<20480>((Rt + bo) ^ 0u), xb8 = tr_read<16384>((Rt + bo) ^ 32u), yb8 = tr_read<20480>((Rt + bo) ^ 32u);
    asm volatile("s_waitcnt lgkmcnt(4)" ::: "memory"); __builtin_amdgcn_sched_barrier(0);
    o[14] = __builtin_amdgcn_mfma_f32_16x16x32_f16((half8){xa7[0], xa7[1], xa7[2], xa7[3], ya7[0], ya7[1], ya7[2], ya7[3]}, pf, o[14], 0, 0, 0);
    o[15] = __builtin_amdgcn_mfma_f32_16x16x32_f16((half8){xb7[0], xb7[1], xb7[2], xb7[3], yb7[0], yb7[1], yb7[2], yb7[3]}, pf, o[15], 0, 0, 0);
    __builtin_amdgcn_sched_barrier(0);
    const half4 xa9 = tr_read<16384>((Rt + bo) ^ 64u), ya9 = tr_read<20480>((Rt + bo) ^ 64u), xb9 = tr_read<16384>((Rt + bo) ^ 96u), yb9 = tr_read<20480>((Rt + bo) ^ 96u);
    asm volatile("s_waitcnt lgkmcnt(4)" ::: "memory"); __builtin_amdgcn_sched_barrier(0);
    o[16] = __builtin_amdgcn_mfma_f32_16x16x32_f16((half8){xa8[0], xa8[1], xa8[2], xa8[3], ya8[0], ya8[1], ya8[2], ya8[3]}, pf, o[16], 0, 0, 0);
    o[17] = __builtin_amdgcn_mfma_f32_16x16x32_f16((half8){xb8[0], xb8[1], xb8[2], xb8[3], yb8[0], yb8[1], yb8[2], yb8[3]}, pf, o[17], 0, 0, 0);
    __builtin_amdgcn_sched_barrier(0);
    const half4 xa10 = tr_read<16384>((Rt + bo) ^ 128u), ya10 = tr_read<20480>((Rt + bo) ^ 128u), xb10 = tr_read<16384>((Rt + bo) ^ 160u), yb10 = tr_read<20480>((Rt + bo) ^ 160u);
    asm volatile("s_waitcnt lgkmcnt(4)" ::: "memory"); __builtin_amdgcn_sched_barrier(0);
    o[18] = __builtin_amdgcn_mfma_f32_16x16x32_f16((half8){xa9[0], xa9[1], xa9[2], xa9[3], ya9[0], ya9[1], ya9[2], ya9[3]}, pf, o[18], 0, 0, 0);
    o[19] = __builtin_amdgcn_mfma_f32_16x16x32_f16((half8){xb9[0], xb9[1], xb9[2], xb9[3], yb9[0], yb9[1], yb9[2], yb9[3]}, pf, o[19], 0, 0, 0);
    __builtin_amdgcn_sched_barrier(0);
    const half4 xa11 = tr_read<16384>((Rt + bo) ^ 192u), ya11 = tr_read<20480>((Rt + bo) ^ 192u), xb11 = tr_read<16384>((Rt + bo) ^ 224u), yb11 = tr_read<20480>((Rt + bo) ^ 224u);
    asm volatile("s_waitcnt lgkmcnt(4)" ::: "memory"); __builtin_amdgcn_sched_barrier(0);
    o[20] = __builtin_amdgcn_mfma_f32_16x16x32_f16((half8){xa10[0], xa10[1], xa10[2], xa10[3], ya10[0], ya10[1], ya10[2], ya10[3]}, pf, o[20], 0, 0, 0);
    o[21] = __builtin_amdgcn_mfma_f32_16x16x32_f16((half8){xb10[0], xb10[1], xb10[2], xb10[3], yb10[0], yb10[1], yb10[2], yb10[3]}, pf, o[21], 0, 0, 0);
    __builtin_amdgcn_sched_barrier(0);
    const half4 xa12 = tr_read<24576>((Rt + bo) ^ 0u), ya12 = tr_read<28672>((Rt + bo) ^ 0u), xb12 = tr_read<24576>((Rt + bo) ^ 32u), yb12 = tr_read<28672>((Rt + bo) ^ 32u);
    asm volatile("s_waitcnt lgkmcnt(4)" ::: "memory"); __builtin_amdgcn_sched_barrier(0);
    o[22] = __builtin_amdgcn_mfma_f32_16x16x32_f16((half8){xa11[0], xa11[1], xa11[2], xa11[3], ya11[0], ya11[1], ya11[2], ya11[3]}, pf, o[22], 0, 0, 0);
    o[23] = __builtin_amdgcn_mfma_f32_16x16x32_f16((half8){xb11[0], xb11[1], xb11[2], xb11[3], yb11[0], yb11[1], yb11[2], yb11[3]}, pf, o[23], 0, 0, 0);
    __builtin_amdgcn_sched_barrier(0);
    const half4 xa13 = tr_read<24576>((Rt + bo) ^ 64u), ya13 = tr_read<28672>((Rt + bo) ^ 64u), xb13 = tr_read<24576>((Rt + bo) ^ 96u), yb13 = tr_read<28672>((Rt + bo) ^ 96u);
    asm volatile("s_waitcnt lgkmcnt(4)" ::: "memory"); __builtin_amdgcn_sched_barrier(0);
    o[24] = __builtin_amdgcn_mfma_f32_16x16x32_f16((half8){xa12[0], xa12[1], xa12[2], xa12[3], ya12[0], ya12[1], ya12[2], ya12[3]}, pf, o[24], 0, 0, 0);
    o[25] = __builtin_amdgcn_mfma_f32_16x16x32_f16((half8){xb12[0], xb12[1], xb12[2], xb12[3], yb12[0], yb12[1], yb12[2], yb12[3]}, pf, o[25], 0, 0, 0);
    __builtin_amdgcn_sched_barrier(0);
    const half4 xa14 = tr_read<24576>((Rt + bo) ^ 128u), ya14 = tr_read<28672>((Rt + bo) ^ 128u), xb14 = tr_read<24576>((Rt + bo) ^ 160u), yb14 = tr_read<28672>((Rt + bo) ^ 160u);
    asm volatile("s_waitcnt lgkmcnt(4)" ::: "memory"); __builtin_amdgcn_sched_barrier(0);
    o[26] = __builtin_amdgcn_mfma_f32_16x16x32_f16((half8){xa13[0], xa13[1], xa13[2], xa13[3], ya13[0], ya13[1], ya13[2], ya13[3]}, pf, o[26], 0, 0, 0);
    o[27] = __builtin_amdgcn_mfma_f32_16x16x32_f16((half8){xb13[0], xb13[1], xb13[2], xb13[3], yb13[0], yb13[1], yb13[2], yb13[3]}, pf, o[27], 0, 0, 0);
    __builtin_amdgcn_sched_barrier(0);
    const half4 xa15 = tr_read<24576>((Rt + bo) ^ 192u), ya15 = tr_read<28672>((Rt + bo) ^ 192u), xb15 = tr_read<24576>((Rt + bo) ^ 224u), yb15 = tr_read<28672>((Rt + bo) ^ 224u);
    asm volatile("s_waitcnt lgkmcnt(4)" ::: "memory"); __builtin_amdgcn_sched_barrier(0);
    o[28] = __builtin_amdgcn_mfma_f32_16x16x32_f16((half8){xa14[0], xa14[1], xa14[2], xa14[3], ya14[0], ya14[1], ya14[2], ya14[3]}, pf, o[28], 0, 0, 0);
    o[29] = __builtin_amdgcn_mfma_f32_16x16x32_f16((half8){xb14[0], xb14[1], xb14[2], xb14[3], yb14[0], yb14[1], yb14[2], yb14[3]}, pf, o[29], 0, 0, 0);
    __builtin_amdgcn_sched_barrier(0);
    asm volatile("s_waitcnt lgkmcnt(0)" ::: "memory"); __builtin_amdgcn_sched_barrier(0);
    o[30] = __builtin_amdgcn_mfma_f32_16x16x32_f16((half8){xa15[0], xa15[1], xa15[2], xa15[3], ya15[0], ya15[1], ya15[2], ya15[3]}, pf, o[30], 0, 0, 0);
    o[31] = __builtin_amdgcn_mfma_f32_16x16x32_f16((half8){xb15[0], xb15[1], xb15[2], xb15[3], yb15[0], yb15[1], yb15[2], yb15[3]}, pf, o[31], 0, 0, 0);
    __builtin_amdgcn_sched_barrier(0);
    asm volatile("s_waitcnt vmcnt(0)" ::: "memory");
    __syncthreads();
  }
  l = quad_sum(l);
  const float inv = 1.0f / l;
  int lane_e = lane, fr_e = fr, fq_e = fq;
  asm volatile("" : "+v"(lane_e), "+v"(fr_e), "+v"(fq_e));
  half8* osave = (half8*)(p.ws + WS_OSAVE) + ((size_t)(blockIdx.x * 8 + wid) * 16) * 64 + lane_e;
  if (STAGE == 0) {
#pragma unroll
    for (int s = 0; s < 16; ++s) { const f32x4 oa = o[2 * s] * inv, ob = o[2 * s + 1] * inv; osave[s * 64] = pack8h(oa, ob); }
    return;
  }
  half8 of1[16];
#pragma unroll
  for (int s = 0; s < 16; ++s) of1[s] = pack8h(o[2 * s] * inv, o[2 * s + 1] * inv);
  f32x4 y0[8], y1[8];
#pragma unroll
  for (int dt = 0; dt < 8; ++dt) { y0[dt] = (f32x4){0.f, 0.f, 0.f, 0.f}; y1[dt] = (f32x4){0.f, 0.f, 0.f, 0.f}; }
  const half_t* wp = (const half_t*)(p.ws + WS_WUV16) + (size_t)(wid * 128 + fr_e) * 512 + fq_e * 8;
  half8 wa[8], wb[8], oa, ob;
#pragma unroll
  for (int dt = 0; dt < 8; ++dt) wa[dt] = *(const half8*)(wp + (size_t)dt * 16 * 512);
  oa = osave[0];
#pragma unroll
  for (int s = 0; s < 16; s += 2) {
#pragma unroll
    for (int dt = 0; dt < 8; ++dt) wb[dt] = *(const half8*)(wp + (size_t)dt * 16 * 512 + 32 * (s + 1));
    ob = osave[(s + 1) * 64];
    __builtin_amdgcn_sched_barrier(0);
#pragma unroll
    for (int dt = 0; dt < 8; ++dt) { y1[dt] = __builtin_amdgcn_mfma_f32_16x16x32_f16(wa[dt], of1[s], y1[dt], 0, 0, 0); y0[dt] = __builtin_amdgcn_mfma_f32_16x16x32_f16(wa[dt], oa, y0[dt], 0, 0, 0); }
    if (s + 2 < 16) {
#pragma unroll
      for (int dt = 0; dt < 8; ++dt) wa[dt] = *(const half8*)(wp + (size_t)dt * 16 * 512 + 32 * (s + 2));
      oa = osave[(s + 2) * 64];
    }
    __builtin_amdgcn_sched_barrier(0);
#pragma unroll
    for (int dt = 0; dt < 8; ++dt) { y1[dt] = __builtin_amdgcn_mfma_f32_16x16x32_f16(wb[dt], of1[s + 1], y1[dt], 0, 0, 0); y0[dt] = __builtin_amdgcn_mfma_f32_16x16x32_f16(wb[dt], ob, y0[dt], 0, 0, 0); }
  }
  float ss0 = 0.f, ss1 = 0.f;
#pragma unroll
  for (int dt = 0; dt < 8; ++dt) { ss0 += y0[dt][0] * y0[dt][0] + y0[dt][1] * y0[dt][1] + y0[dt][2] * y0[dt][2] + y0[dt][3] * y0[dt][3];
    ss1 += y1[dt][0] * y1[dt][0] + y1[dt][1] * y1[dt][1] + y1[dt][2] * y1[dt][2] + y1[dt][3] * y1[dt][3]; }
  ss0 = quad_sum(ss0); ss1 = quad_sum(ss1);
  LAS float* red = (LAS float*)(L + 65536 + 4096);
  if (fq_e == 0) { red[fr_e * 8 + wid] = ss0; red[128 + fr_e * 8 + wid] = ss1; }
  __syncthreads();
  float tot0 = 0.f, tot1 = 0.f;
#pragma unroll
  for (int w = 0; w < 8; ++w) { tot0 += red[fr_e * 8 + w]; tot1 += red[128 + fr_e * 8 + w]; }
  const float rstd0 = rsqrtf(tot0 * (1.0f / 1024.f) + EPS), rstd1 = rsqrtf(tot1 * (1.0f / 1024.f) + EPS);
  half_t* mp0 = (half_t*)(p.ws + WS_MIX16) + (size_t)(b * SEQ + tb_prev * 16 + fr_e) * D + 1024 + wid * 128 + 4 * fq_e;
  half_t* mp1 = (half_t*)(p.ws + WS_MIX16) + (size_t)(t0 + fr_e) * D + 1024 + wid * 128 + 4 * fq_e;
#pragma unroll
  for (int dt = 0; dt < 8; ++dt) { const float4 g = *(const float4*)(p.g_attn_out + wid * 128 + dt * 16 + 4 * fq_e);
    half4 ov; ov[0] = (half_t)(y0[dt][0] * rstd0 * g.x); ov[1] = (half_t)(y0[dt][1] * rstd0 * g.y); ov[2] = (half_t)(y0[dt][2] * rstd0 * g.z); ov[3] = (half_t)(y0[dt][3] * rstd0 * g.w);
    *(half4*)(mp0 + dt * 16) = ov;
    ov[0] = (half_t)(y1[dt][0] * rstd1 * g.x); ov[1] = (half_t)(y1[dt][1] * rstd1 * g.y); ov[2] = (half_t)(y1[dt][2] * rstd1 * g.z); ov[3] = (half_t)(y1[dt][3] * rstd1 * g.w);
    *(half4*)(mp1 + dt * 16) = ov; }
}
__device__ void phase4(const Params& p, char* lds) {
  for (int it = blockIdx.x; it < 256; it += gridDim.x) {
    const int b = it >> 6, jp = it & 63;
    attn_task<0>(p, lds, b, jp, 0);
    attn_task<1>(p, lds, b, 127 - jp, jp);
  }
}

__device__ void phase6(const Params& p, char* lds) {
  g8::DenseOrder S; S.init(NTOK, D, D, gridDim.x, blockIdx.x);
  g8::EpiResid E{p.x, (const float*)(p.ws + WS_MOD), (half_t*)(p.ws + WS_X1H)};
  g8::gemm_phase((LAS unsigned char*)lds, (const half_t*)(p.ws + WS_MIX16), (const half_t*)(p.ws + WS_WOUT16), D, D, D, S, E);
}

__device__ void phase7(const Params& p, char* lds) {
  const int tid = threadIdx.x, lane = tid & 63, wid = tid >> 6, fr = lane & 15, fq = lane >> 4;
  half_t* tile = (half_t*)lds;
  float* logit = (float*)(lds + 32 * 2056 * 2);
  int* e1s = (int*)(logit + 32 * 48); int* e2s = e1s + 32;
  const float* modf = (const float*)(p.ws + WS_MOD); half_t* h2 = (half_t*)(p.ws + WS_H2_16); const half_t* wr = (const half_t*)(p.ws + WS_WR16);
  Route* route = (Route*)(p.ws + WS_ROUTE); int* blkcnt = (int*)(p.ws + WS_BLKCNT); int* rowmap = (int*)(p.ws + WS_ROWMAP);
  for (int rg = blockIdx.x; rg < 256; rg += gridDim.x) {
    const int t0 = rg * 32, b = t0 >> 11;
    if (tid < 96) rowmap[rg * 96 + tid] = -1;
    f32x4 s2[4][2], h2m[4][2];
#pragma unroll
    for (int j = 0; j < 4; ++j)
#pragma unroll
      for (int h = 0; h < 2; ++h) { const int c = lane * 8 + 512 * j + 4 * h;
        s2[j][h] = *(const f32x4*)(p.g_ffn + c) * (*(const f32x4*)(modf + b * MODN + 8192 + c) + 1.0f); h2m[j][h] = *(const f32x4*)(modf + b * MODN + 6144 + c); }
    for (int i = 0; i < 4; ++i) {
      const int lr = wid * 4 + i, t = t0 + lr;
      const half_t* xr = (const half_t*)(p.ws + WS_X1H) + (size_t)t * D;
      half8 v[4]; float ss = 0.f;
#pragma unroll
      for (int j = 0; j < 4; ++j) { v[j] = *(const half8*)(xr + lane * 8 + 512 * j);
#pragma unroll
        for (int e = 0; e < 8; ++e) ss += (float)v[j][e] * (float)v[j][e]; }
      ss = wave_sum(ss);
      const float rstd = rsqrtf(ss * (1.0f / D) + EPS);
#pragma unroll
      for (int j = 0; j < 4; ++j) { const int c = lane * 8 + 512 * j;
        half8 o;
#pragma unroll
        for (int e = 0; e < 8; ++e) o[e] = (half_t)((float)v[j][e] * rstd * s2[j][e >> 2][e & 3] + h2m[j][e >> 2][e & 3]);
        *(half8*)(tile + lr * 2056 + c) = o; *(half8*)(h2 + (size_t)t * D + c) = o; }
    }
    __syncthreads();
    if (wid < 6) {
      const int m = wid / 3, n = wid % 3; f32x4 acc = (f32x4){0.f, 0.f, 0.f, 0.f};
      const half_t* ap = tile + (m * 16 + fr) * 2056 + fq * 8; const half_t* bp = wr + (size_t)(n * 16 + fr) * D + fq * 8;
#pragma unroll 4
      for (int s = 0; s < 64; ++s) acc = __builtin_amdgcn_mfma_f32_16x16x32_f16(*(const half8*)(ap + s * 32), *(const half8*)(bp + s * 32), acc, 0, 0, 0);
#pragma unroll
      for (int r = 0; r < 4; ++r) logit[(m * 16 + fq * 4 + r) * 48 + n * 16 + fr] = acc[r];
    }
    __syncthreads();
    int e1g = 0, e2g = 0; float c1 = 0.f, c2 = 0.f;
    if (tid < 32) {
      const float* l = logit + tid * 48;
      float gl[4]; int g = 0; float gm = -INFINITY;
#pragma unroll
      for (int i = 0; i < 4; ++i) { gl[i] = l[i] + p.b_rg[i]; if (gl[i] > gm) { gm = gl[i]; g = i; } }
      float gs = 0.f;
#pragma unroll
      for (int i = 0; i < 4; ++i) gs += __expf(gl[i] - gm);
      const float pg = 1.0f / gs;
      float el[8]; int i1 = 0; float m1 = -INFINITY;
#pragma unroll
      for (int i = 0; i < 8; ++i) { el[i] = l[4 + g * 8 + i] + p.b_re[g * 8 + i]; if (el[i] > m1) { m1 = el[i]; i1 = i; } }
      int i2 = 0; float m2 = -INFINITY;
#pragma unroll
      for (int i = 0; i < 8; ++i) if (i != i1 && el[i] > m2) { m2 = el[i]; i2 = i; }
      const float w1 = 1.0f / (1.0f + __expf(m2 - m1)), w2 = 1.0f - w1;
      e1g = g * 8 + i1; e2g = g * 8 + i2; c1 = pg * w1; c2 = pg * w2;
      e1s[tid] = e1g; e2s[tid] = e2g;
    }
    __syncthreads();
    if (tid < 32) {
      int r1 = 0, r2 = 0, cnt = 0;
      for (int r = 0; r < 32; ++r) { const int a = e1s[r], bb = e2s[r];
        if (r < tid) { r1 += (a == e1g || bb == e1g); r2 += (a == e2g || bb == e2g); }
        cnt += (a == tid || bb == tid); }
      Route rt; rt.e1 = e1g; rt.e2 = e2g; rt.c1 = c1; rt.c2 = c2; rt.r1 = r1; rt.r2 = r2; rt.pad0 = 0; rt.pad1 = 0;
      route[t0 + tid] = rt;
      blkcnt[rg * 32 + tid] = cnt;
    }
    __syncthreads();
  }
}

__device__ void phase8(const Params& p, char* lds) {
  const int tid = threadIdx.x;
  int* pre = (int*)lds; int* tot = pre + 32; int* base = tot + 32;
  const int* blkcnt = (const int*)(p.ws + WS_BLKCNT); const Route* route = (const Route*)(p.ws + WS_ROUTE);
  int* rowmap = (int*)(p.ws + WS_ROWMAP); float* cslot = (float*)(p.ws + WS_CSLOT); int* meta = (int*)(p.ws + WS_META);
  for (int rg = blockIdx.x; rg < 256; rg += gridDim.x) {
    if (tid < 32) { int a = 0, s = 0; for (int b = 0; b < 256; ++b) { const int c = blkcnt[b * 32 + tid]; s += c; if (b < rg) a += c; } pre[tid] = a; tot[tid] = s; }
    __syncthreads();
    if (tid == 0) { int run = 0; for (int e = 0; e < 32; ++e) { base[e] = run; run += tot[e]; } base[32] = run; }
    __syncthreads();
    if (tid < 32) {
      const int t = rg * 32 + tid; const Route rt = route[t];
      const int s1 = base[rt.e1] + pre[rt.e1] + rt.r1, s2 = base[rt.e2] + pre[rt.e2] + rt.r2;
      rowmap[s1] = 2 * t; rowmap[s2] = 2 * t + 1; cslot[s1] = rt.c1; cslot[s2] = rt.c2;
      if (rg == 0) { meta[tid] = base[tid]; meta[64 + tid] = tot[tid]; if (tid == 0) meta[32] = base[32]; }
    }
    __syncthreads();
  }
}

template <int MODE, int NM>
__device__ __forceinline__ void moe_consume(const Params& p, LAS char* L, int wid, int lane, int slot0, int nrows, int pass0, int e, int nc) {
  constexpr int K = MODE ? 512 : D, NST = K / 64, LDB = MODE ? D : 512;
  const int wr2 = wid >> 1, wc2 = wid & 1, l31 = lane & 31, lh = lane >> 5;
  const int* rowmap = (const int*)(p.ws + WS_ROWMAP);
  const unsigned n0 = 64 * wc2 + (l31 & ~3);
  const unsigned pb0 = (n0 | ((l31 + (l31 >> 4)) & 3)) * 16u + lh * 2048u, pb1 = ((n0 + 32) | ((l31 + 2 + (l31 >> 4)) & 3)) * 16u + lh * 2048u;
  const unsigned pa0 = (unsigned)(wr2 * 32 + l31) * 128u + 16u * (lh ^ ((l31 >> 1) & 7)), pa1 = pa0 ^ 32u, pa2 = pa0 ^ 64u, pa3 = pa0 ^ 96u;
  const char* pfb = MODE ? (const char*)(p.w_down + (size_t)e * 512 * D + 128 * nc) : (const char*)(((wid >> 1) ? p.w_up : p.w_gate) + (size_t)e * D * 512 + 64 * nc);
  const unsigned pfo = MODE ? (unsigned)(((wid * 64 + lane) >> 2) * (D * 4) + ((wid * 64 + lane) & 3) * 128) : (unsigned)(((((wid & 1) * 64 + lane) >> 1)) * (512 * 4) + (lane & 1) * 128);
  const __amdgpu_buffer_rsrc_t prs = __builtin_amdgcn_make_buffer_rsrc((void*)pfb, (short)0, (int)(K * LDB * 4), 0x00020000);
#define MOE_PF(S) __builtin_amdgcn_raw_ptr_buffer_load_lds(prs, (LAS void*)(L + 155648 + wid * 256), 4, pfo, (S) * (64 * LDB * 4), 0, 0)
  f32x16 acc[5][2];
#pragma unroll
  for (int m = 0; m < 5; ++m)
#pragma unroll
    for (int j = 0; j < 2; ++j)
#pragma unroll
      for (int i = 0; i < 16; ++i) acc[m][j][i] = 0.f;
  half8 a0[NM], a1[NM], b00, b01, b10, b11;
#define MOE_RD(AV, B0, B1, PA, T) do { B0 = *(const LAS half8*)(rB + pb0 + (T) * 4096); B1 = *(const LAS half8*)(rB + pb1 + (T) * 4096); \
    _Pragma("unroll") for (int m = 0; m < NM; ++m) AV[m] = *(const LAS half8*)(rA + (PA) + m * 8192); __builtin_amdgcn_sched_barrier(0); } while (0)
#define MOE_MM(AV, B0, B1) do { _Pragma("unroll") for (int m = 0; m < NM; ++m) { acc[m][0] = __builtin_amdgcn_mfma_f32_32x32x16_f16(B0, AV[m], acc[m][0], 0, 0, 0); \
      acc[m][1] = __builtin_amdgcn_mfma_f32_32x32x16_f16(B1, AV[m], acc[m][1], 0, 0, 0); } __builtin_amdgcn_sched_barrier(0); } while (0)
  LDS_BARRIER();
  const LAS char* rB = L; const LAS char* rA = L + 32768;
  MOE_RD(a0, b00, b01, pa0, 0);
#pragma unroll 1
  for (int s = 0; s < NST; ++s) {
    MOE_RD(a1, b10, b11, pa1, 1); MOE_MM(a0, b00, b01);
    MOE_RD(a0, b00, b01, pa2, 2); MOE_MM(a1, b10, b11);
    MOE_RD(a1, b10, b11, pa3, 3); MOE_MM(a0, b00, b01);
    LDS_BARRIER();
    rB = L + ((s + 1) & 1) * 16384; rA = (rA == L + 32768 + 2 * 40960) ? L + 32768 : rA + 40960;
    if (s + 1 < NST) MOE_RD(a0, b00, b01, pa0, 0);
    MOE_MM(a1, b10, b11);
  }
#undef MOE_RD
#undef MOE_MM
#undef MOE_PF
#pragma unroll
  for (int m = 0; m < NM; ++m) { const int lr = pass0 + (2 * m + wr2) * 32 + l31; if (lr < nrows) {
    const int slot = slot0 + lr;
    if (MODE == 0) {
      const float cw = ((const float*)(p.ws + WS_CSLOT))[slot];
      half_t* ap = (half_t*)(p.ws + WS_ACT16) + (size_t)slot * 512 + 64 * nc + 32 * wc2 + 4 * lh;
#pragma unroll
      for (int rq = 0; rq < 4; ++rq) { half4 o;
#pragma unroll
        for (int i = 0; i < 4; ++i) { const float g = acc[m][0][rq * 4 + i], u = acc[m][1][rq * 4 + i]; o[i] = (half_t)(g / (1.0f + __expf(-g)) * u * cw); }
        *(half4*)(ap + 8 * rq) = o; }
    } else {
      half_t* op = (half_t*)(p.ws + WS_OUT2) + (size_t)rowmap[slot] * D + 128 * nc + 64 * wc2 + 4 * lh;
#pragma unroll
      for (int nb = 0; nb < 2; ++nb)
#pragma unroll
        for (int rq = 0; rq < 4; ++rq) { half4 o;
#pragma unroll
          for (int i = 0; i < 4; ++i) o[i] = (half_t)acc[m][nb][rq * 4 + i];
          *(half4*)(op + 32 * nb + 8 * rq) = o; }
    } } }
}
template <int MODE, int ND>
__device__ __forceinline__ void moe_load_a(const Params& p, LAS char* L, int la, int lane, int slot0, int nrows, int pass0) {
  constexpr int K = MODE ? 512 : D, NST = K / 64;
  const int* rowmap = (const int*)(p.ws + WS_ROWMAP);
  const __amdgpu_buffer_rsrc_t ars = __builtin_amdgcn_make_buffer_rsrc((void*)(p.ws + (MODE ? WS_ACT16 : WS_H2_16)), (short)0, MODE ? (16384 * 512 * 2) : (NTOK * D * 2), 0x00020000);
  const unsigned sc = (unsigned)(lane & 7) ^ (unsigned)((la * 4 + (lane >> 4)) & 7);
  unsigned avo[ND];
#pragma unroll
  for (int i = 0; i < ND; ++i) { int lr = pass0 + 8 * (2 * i + la) + (lane >> 3); if (lr >= nrows) lr = 0; const int slot = slot0 + lr;
    avo[i] = (MODE ? (unsigned)slot * 1024u : (unsigned)(rowmap[slot] >> 1) * (unsigned)(D * 2)) + sc * 16u; }
#define MOE_DMA(S, RA) do { _Pragma("unroll") for (int i = 0; i < ND; ++i) \
    __builtin_amdgcn_raw_ptr_buffer_load_lds(ars, (LAS void*)(L + (RA) + (2 * i + la) * 1024), 16, avo[i], (S) * 128, 0, 0); } while (0)
  MOE_DMA(0, 32768);
  MOE_DMA(1, 32768 + 40960);
  if (ND == 20) asm volatile("s_waitcnt vmcnt(20)" ::: "memory"); else if (ND == 16) asm volatile("s_waitcnt vmcnt(16)" ::: "memory"); else asm volatile("s_waitcnt vmcnt(12)" ::: "memory");
  LDS_BARRIER();
  unsigned rn = 32768 + 2 * 40960;
#pragma unroll 1
  for (int s = 0; s < NST; ++s) {
    if (s + 2 < NST) { MOE_DMA(s + 2, rn); rn = (rn == 32768 + 2 * 40960) ? 32768 : rn + 40960;
      if (ND == 20) asm volatile("s_waitcnt vmcnt(20)" ::: "memory"); else if (ND == 16) asm volatile("s_waitcnt vmcnt(16)" ::: "memory"); else asm volatile("s_waitcnt vmcnt(12)" ::: "memory");
    } else asm volatile("s_waitcnt vmcnt(0)" ::: "memory");
    LDS_BARRIER();
  }
#undef MOE_DMA
}
template <int MODE>
__device__ __forceinline__ void moe_load_b(const Params& p, LAS char* L, int mat, int lane, int e, int nc) {
  constexpr int K = MODE ? 512 : D, NST = K / 64, LDB = MODE ? D : 512;
  const int nq = lane & 15, kql = lane >> 4, c0 = 4 * nq;
  const float* bptr = MODE ? (p.w_down + (size_t)e * 512 * D + 128 * nc + mat * 64) : ((mat ? p.w_up : p.w_gate) + (size_t)e * D * 512 + 64 * nc);
  const __amdgpu_buffer_rsrc_t brs = __builtin_amdgcn_make_buffer_rsrc((void*)bptr, (short)0, (int)(K * LDB * 4 - 1024), 0x00020000);
  const unsigned bvo = (unsigned)(4 * kql * LDB + c0) * 4u;
  const int nl = MODE ? (mat * 64 + c0) : ((c0 >> 5) * 64 + mat * 32 + (c0 & 31));
  const unsigned wl = (kql >> 1) * 2048u + (kql & 1) * 8u + nl * 16u;
  u32x4 X[16], Y[16];
#define MOE_LOADB(V, S) do { _Pragma("unroll") for (int q = 0; q < 16; ++q) V[q] = __builtin_amdgcn_raw_buffer_load_b128(brs, bvo, ((S) * 64 + 16 * (q >> 2) + (q & 3)) * (LDB * 4), 0); } while (0)
#define MOE_STOREB(V, BUF) do { _Pragma("unroll") for (int kg = 0; kg < 4; ++kg) _Pragma("unroll") for (int nn = 0; nn < 4; ++nn) { half4 h; \
      h[0] = (half_t)__uint_as_float(V[kg * 4 + 0][nn]); h[1] = (half_t)__uint_as_float(V[kg * 4 + 1][nn]); h[2] = (half_t)__uint_as_float(V[kg * 4 + 2][nn]); h[3] = (half_t)__uint_as_float(V[kg * 4 + 3][nn]); \
      *(LAS half4*)(L + (BUF) * 16384 + kg * 4096 + wl + ((nn + (nl >> 4)) & 3) * 16) = h; } } while (0)
  MOE_LOADB(X, 0);
  MOE_LOADB(Y, 1);
  MOE_STOREB(X, 0);
  LDS_BARRIER();
#pragma unroll 1
  for (int s = 0; s < NST - 2; s += 2) {
    MOE_LOADB(X, s + 2); MOE_STOREB(Y, 1); LDS_BARRIER();
    MOE_LOADB(Y, s + 3); MOE_STOREB(X, 0); LDS_BARRIER();
  }
  MOE_STOREB(Y, 1); LDS_BARRIER();
  LDS_BARRIER();
#undef MOE_LOADB
#undef MOE_STOREB
}
template <int MODE>
__device__ __forceinline__ void moe_unit(const Params& p, char* lds, int e, int nc, int rh) {
  const int tid = threadIdx.x, lane = tid & 63, wid = __builtin_amdgcn_readfirstlane(tid >> 6);
  const int* meta = (const int*)(p.ws + WS_META);
  const int tot = meta[64 + e], base = meta[e];
  const int Rh = (((tot + 1) >> 1) + 15) & ~15;
  const int r0 = rh ? Rh : 0, r1 = rh ? tot : (Rh < tot ? Rh : tot);
  const int nrows = r1 - r0, slot0 = base + r0;
  LAS char* L = (LAS char*)lds;
  for (int pass0 = 0; pass0 < nrows; pass0 += 320) {
    const int prow = (nrows - pass0 < 320) ? (nrows - pass0) : 320;
    const int MT = (((prow + 31) >> 5) + 1) >> 1;
    LDS_BARRIER();
    if (wid < 4) {
      if (MT == 5) moe_consume<MODE, 5>(p, L, wid, lane, slot0, nrows, pass0, e, nc);
      else if (MT == 4) moe_consume<MODE, 4>(p, L, wid, lane, slot0, nrows, pass0, e, nc);
      else moe_consume<MODE, 3>(p, L, wid, lane, slot0, nrows, pass0, e, nc);
    } else if (wid < 6) {
      if (MT == 5) moe_load_a<MODE, 20>(p, L, wid - 4, lane, slot0, nrows, pass0);
      else if (MT == 4) moe_load_a<MODE, 16>(p, L, wid - 4, lane, slot0, nrows, pass0);
      else moe_load_a<MODE, 12>(p, L, wid - 4, lane, slot0, nrows, pass0);
    } else moe_load_b<MODE>(p, L, wid - 6, lane, e, nc);
  }
}
__device__ __forceinline__ int moe_vblock(const Params& p, char* lds) {
  if (gridDim.x != 256) return -1;
  const unsigned* rk = (const unsigned*)(p.ws + WS_BAR) + XCC_RANK;
  bool ok = true;
#pragma unroll
  for (int j = 0; j < 8; ++j) ok = ok && (__hip_atomic_load(rk + 64 * j, __ATOMIC_RELAXED, __HIP_MEMORY_SCOPE_AGENT) == 32u);
  const volatile LAS unsigned* st = (const volatile LAS unsigned*)(LAS char*)(lds + LDS_MAIN);
  return ok ? (int)(st[2] + 8u * st[3]) : -1;
}
__device__ __forceinline__ const LAS int* moe_rank_experts(const Params& p, char* lds) {
  LAS int* order = (LAS int*)((LAS char*)lds + 155648);
  const int* meta = (const int*)(p.ws + WS_META);
  const int tid = threadIdx.x;
  if (tid < 32) { const int t = meta[64 + tid]; int rank = 0;
    for (int j = 0; j < 32; ++j) { const int tj = meta[64 + j]; rank += (tj > t || (tj == t && j < tid)) ? 1 : 0; }
    order[rank] = tid; }
  __syncthreads();
  return order;
}
__device__ void phase9(const Params& p, char* lds) {
  const int vb = moe_vblock(p, lds);
  const LAS int* order = moe_rank_experts(p, lds);
  for (int r = 0; r * (int)gridDim.x < 512; ++r) {
    const int u = blockIdx.x + r * gridDim.x; if (u >= 512) break;
    int e = u >> 4, nc = (u >> 1) & 7, rh = u & 1;
    if (vb >= 0) { const int x = vb & 7, i = vb >> 3; e = r * 16 + x * 2 + (i >> 4); nc = (i >> 1) & 7; rh = i & 1; }
    e = __builtin_amdgcn_readfirstlane(order[(e & 16) ? 31 - (e & 15) : (e & 15)]);
    moe_unit<0>(p, lds, e, nc, rh);
  }
}
__device__ void phase10(const Params& p, char* lds) {
  const int vb = moe_vblock(p, lds);
  const LAS int* order = moe_rank_experts(p, lds);
  for (int r = 0; r * (int)gridDim.x < 1024; ++r) {
    const int u = blockIdx.x + r * gridDim.x; if (u >= 1024) break;
    int e = u >> 5, nc = (u >> 1) & 15, rh = u & 1;
    if (vb >= 0) { const int x = vb & 7, i = vb >> 3; e = r * 8 + x; nc = i >> 1; rh = i & 1; }
    e = __builtin_amdgcn_readfirstlane(order[(e & 8) ? (e | 7) - (e & 7) : e]);
    moe_unit<1>(p, lds, e, nc, rh);
  }
}

__device__ void phase11(const Params& p, char* lds) {
  const int tid = threadIdx.x, lane = tid & 63, wid = tid >> 6;
  const float* modf = (const float*)(p.ws + WS_MOD); const half_t* out2 = (const half_t*)(p.ws + WS_OUT2); const half_t* x1h = (const half_t*)(p.ws + WS_X1H);
  for (int rg = blockIdx.x; rg < 256; rg += gridDim.x) {
    const int t0 = rg * 32 + wid * 4, b = t0 >> 11;
    f32x4 gt[4][2], sf[4][2], hf[4][2];
#pragma unroll
    for (int j = 0; j < 4; ++j)
#pragma unroll
      for (int h = 0; h < 2; ++h) { const int c = lane * 8 + 512 * j + 4 * h;
        gt[j][h] = *(const f32x4*)(modf + b * MODN + 10240 + c);
        sf[j][h] = *(const f32x4*)(p.g_final + c) * (*(const f32x4*)(modf + b * MODN + 12288 + 2048 + c) + 1.0f);
        hf[j][h] = *(const f32x4*)(modf + b * MODN + 12288 + c); }
    half8 xv[4], m0[4], m1[4];
#pragma unroll
    for (int j = 0; j < 4; ++j) { const int c = lane * 8 + 512 * j; xv[j] = *(const half8*)(x1h + (size_t)t0 * D + c);
      m0[j] = *(const half8*)(out2 + (size_t)(2 * t0) * D + c); m1[j] = *(const half8*)(out2 + (size_t)(2 * t0 + 1) * D + c); }
#pragma unroll
    for (int i = 0; i < 4; ++i) {
      const int t = t0 + i;
      float x2[4][8]; float ss = 0.f;
#pragma unroll
      for (int j = 0; j < 4; ++j)
#pragma unroll
        for (int e = 0; e < 8; ++e) { const float v = (float)xv[j][e] + gt[j][e >> 2][e & 3] * ((float)m0[j][e] + (float)m1[j][e]); x2[j][e] = v; ss += v * v; }
      if (i < 3) {
#pragma unroll
        for (int j = 0; j < 4; ++j) { const int c = lane * 8 + 512 * j; xv[j] = *(const half8*)(x1h + (size_t)(t + 1) * D + c);
          m0[j] = *(const half8*)(out2 + (size_t)(2 * t + 2) * D + c); m1[j] = *(const half8*)(out2 + (size_t)(2 * t + 3) * D + c); }
      }
      ss = wave_sum(ss);
      const float rstd = rsqrtf(ss * (1.0f / D) + EPS);
      float* xr = p.out + (size_t)t * D;
#pragma unroll
      for (int j = 0; j < 4; ++j)
#pragma unroll
        for (int h = 0; h < 2; ++h) { f32x4 o;
#pragma unroll
          for (int e = 0; e < 4; ++e) o[e] = x2[j][4 * h + e] * rstd * sf[j][h][e] + hf[j][h][e];
          *(f32x4*)(xr + lane * 8 + 512 * j + 4 * h) = o; }
    }
  }
}


#define XB_TMO      128
#define XB_XCNT(j)  (256  + 64 * (j))
#define XB_XSUB(j)  (1280 + 64 * (j))
#define XB_XGEN(j)  (2304 + 64 * (j))
#define XB_TOP      3328
#define XB_TOPGEN   3392
#define XCD_BAR_WORDS 3456
#define XB_SPIN_CAP (1u << 25)
__device__ __forceinline__ unsigned xb_ld(unsigned* p) { return __hip_atomic_load(p, __ATOMIC_RELAXED, __HIP_MEMORY_SCOPE_AGENT); }
__device__ __forceinline__ unsigned xb_add(unsigned* p, unsigned v) { return __hip_atomic_fetch_add(p, v, __ATOMIC_RELAXED, __HIP_MEMORY_SCOPE_AGENT); }
__device__ __forceinline__ unsigned xb_xcc_id() { return (unsigned)__builtin_amdgcn_s_getreg((3 << 11) | 20) & 0xFu; }
#define XB_SPIN(cond, bar) do { unsigned _sp = 0; while (cond) { __builtin_amdgcn_s_sleep(1); \
    if ((++_sp & 255u) == 0u) { if (xb_ld(&(bar)[XB_TMO])) break; if (_sp > XB_SPIN_CAP) { atomicAdd(&(bar)[XB_TMO], 1u); break; } } } } while (0)
struct XcdBarrier { unsigned* bar; unsigned x; volatile LAS unsigned* st; };
__device__ __forceinline__ XcdBarrier xcd_barrier_post(unsigned* bar, volatile LAS unsigned* st) {
  XcdBarrier b; b.bar = bar; b.x = xb_xcc_id(); b.st = st;
  if (threadIdx.x == 0) (void)xb_add(&bar[XB_XCNT(b.x)], 1u);
  return b;
}
__device__ __forceinline__ void xcd_barrier_complete(unsigned* bar, unsigned x, unsigned& nloc, unsigned& nx) {
  const unsigned G = gridDim.x * gridDim.y * gridDim.z;
  unsigned sum, cnt, mine, sp = 0u;
  for (;;) {
    sum = 0u; cnt = 0u; mine = 0u;
#pragma unroll
    for (unsigned j = 0; j < 16; ++j) { const unsigned c = xb_ld(&bar[XB_XCNT(j)]); sum += c; cnt += (c > 0u) ? 1u : 0u; mine = (j == x) ? c : mine; }
    if (sum == G) break;
    __builtin_amdgcn_s_sleep(1);
    if ((++sp & 255u) == 0u) { if (xb_ld(&bar[XB_TMO])) break; if (sp > XB_SPIN_CAP) { atomicAdd(&bar[XB_TMO], 1u); break; } }
  }
  nloc = mine > 0u ? mine : 1u; nx = cnt > 0u ? cnt : 1u;
}
__device__ __forceinline__ void xcd_barrier(const XcdBarrier& b) {
  asm volatile("s_waitcnt vmcnt(0)" ::: "memory");
  __syncthreads();
  if (threadIdx.x == 0) {
    unsigned* bar = b.bar;
    __builtin_amdgcn_s_waitcnt(0);
    unsigned nloc = b.st[0], nx = b.st[1];
    if (nloc == 0u) { xcd_barrier_complete(bar, b.x, nloc, nx); b.st[0] = nloc; b.st[1] = nx; }
    const unsigned old = xb_add(&bar[XB_XSUB(b.x)], 1u);
    const unsigned gen = old / nloc;
    if (old + 1u == (gen + 1u) * nloc) {
      __builtin_amdgcn_fence(__ATOMIC_RELEASE, "agent");
      asm volatile("s_waitcnt vmcnt(0)" ::: "memory");
      const unsigned og = xb_add(&bar[XB_TOP], 1u);
      const unsigned tg = og / nx;
      if (og + 1u == (tg + 1u) * nx) xb_add(&bar[XB_TOPGEN], 1u);
      else XB_SPIN(xb_ld(&bar[XB_TOPGEN]) == tg, bar);
      __builtin_amdgcn_fence(__ATOMIC_ACQUIRE, "agent");
      xb_add(&bar[XB_XGEN(b.x)], 1u);
      asm volatile("s_waitcnt vmcnt(0)" ::: "memory");
    } else {
      XB_SPIN(xb_ld(&bar[XB_XGEN(b.x)]) == gen, bar);
      __builtin_amdgcn_fence(__ATOMIC_ACQUIRE, "agent");
      asm volatile("s_waitcnt vmcnt(0)" ::: "memory");
    }
  }
  __syncthreads();
}

__global__ void __launch_bounds__(NT) mega(Params p) {
  extern __shared__ __attribute__((aligned(16))) char smem[];
  volatile LAS unsigned* st = (volatile LAS unsigned*)(LAS char*)(smem + LDS_MAIN);
  if (threadIdx.x < 4) st[threadIdx.x] = 0u;
  __syncthreads();
  XcdBarrier bar = xcd_barrier_post((unsigned*)(p.ws + WS_BAR), st);
  if (threadIdx.x == 0) { st[2] = bar.x; st[3] = xb_add((unsigned*)(p.ws + WS_BAR) + XCC_RANK + 64 * bar.x, 1u); }
  __syncthreads();
  const int lo = p.ph_lo, hi = p.ph_hi;
#define PH(k, call) if (lo <= (k) && (k) < hi) { call; if ((k) + 1 < hi) xcd_barrier(bar); }
  PH(0, phase0(p, smem))
  PH(1, phase1(p, smem))
  PH(2, phase2(p, smem))
  PH(3, phase3(p, smem))
  PH(4, phase4(p, smem))
  PH(6, phase6(p, smem))
  PH(7, phase7(p, smem))
  PH(8, phase8(p, smem))
  PH(9, phase9(p, smem))
  PH(10, phase10(p, smem))
  PH(11, phase11(p, smem))
#undef PH
}

extern "C" void kernel_launch(void* const* d_in, const int* in_sizes, int n_in, void* d_out, int out_size, void* d_ws, size_t ws_size, hipStream_t stream) {
  if (n_in != 24 || ws_size < WS_END) { fprintf(stderr, "kernel_launch: need 24 inputs and %zu bytes of workspace (got %d, %zu)\n", (size_t)WS_END, n_in, ws_size); return; }
  static int grid = 0;
  if (grid == 0) {
    int dev = 0, cus = 0, per_cu = 0;
    (void)hipGetDevice(&dev);
    (void)hipDeviceGetAttribute(&cus, hipDeviceAttributeMultiprocessorCount, dev);
    (void)hipFuncSetAttribute((const void*)mega, hipFuncAttributeMaxDynamicSharedMemorySize, LDS_BYTES);
    (void)hipOccupancyMaxActiveBlocksPerMultiprocessor(&per_cu, (const void*)mega, NT, LDS_BYTES);
    if (per_cu < 1) { fprintf(stderr, "kernel_launch: occupancy query says %d blocks per CU\n", per_cu); grid = -1; return; }
    grid = cus;
  }
  if (grid < 0) return;
  (void)hipMemsetAsync((char*)d_ws + WS_BAR, 0, 32768, stream);
  Params p{};
  const float** pp = (const float**)&p;
  for (int i = 0; i < 24; ++i) pp[i] = (const float*)d_in[i];
  p.out = (float*)d_out; p.ws = (char*)d_ws; p.ph_lo = 0; p.ph_hi = 12;
#ifdef PROBE_PHASE
  {
    p.ph_hi = PROBE_PHASE + 1;
    void* a1[] = {&p};
    (void)hipLaunchCooperativeKernel((const void*)mega, dim3(grid), dim3(NT), a1, LDS_BYTES, stream);
    (void)hipMemsetAsync((char*)d_ws + WS_BAR, 0, 32768, stream);
    p.ph_lo = PROBE_PHASE; p.ph_hi = 12;
  }
#endif
#ifdef PROBE_SUB
  {
    p.ph_hi = 4;
    void* a1[] = {&p};
    (void)hipLaunchCooperativeKernel((const void*)mega, dim3(grid), dim3(NT), a1, LDS_BYTES, stream);
    (void)hipMemsetAsync((char*)d_ws + WS_BAR, 0, 32768, stream);
    p.ph_lo = 3; p.ph_hi = 4; p.sub = PROBE_SUB;
    (void)hipLaunchCooperativeKernel((const void*)mega, dim3(grid), dim3(NT), a1, LDS_BYTES, stream);
    (void)hipMemsetAsync((char*)d_ws + WS_BAR, 0, 32768, stream);
    p.ph_lo = 4; p.ph_hi = 12; p.sub = 0;
  }
#endif
  void* args[] = {&p};
  hipError_t e = hipLaunchCooperativeKernel((const void*)mega, dim3(grid), dim3(NT), args, LDS_BYTES, stream);
  if (e != hipSuccess) fprintf(stderr, "cooperative launch failed: %s (grid %d)\n", hipGetErrorString(e), grid);
}
```

```cpp
#include <hip/hip_runtime.h>
#include <stdint.h>
#include <stdio.h>

typedef _Float16 half_t;
typedef _Float16 half8 __attribute__((ext_vector_type(8)));
typedef _Float16 half4 __attribute__((ext_vector_type(4)));
typedef _Float16 half2v __attribute__((ext_vector_type(2)));
typedef float f32x4 __attribute__((ext_vector_type(4)));
typedef float f32x16 __attribute__((ext_vector_type(16)));
typedef unsigned u32x4 __attribute__((ext_vector_type(4)));

#define NT 512
#define XCC_RANK 4096
#define LAS __attribute__((address_space(3)))
constexpr int D = 2048, SEQ = 2048, NTOK = 8192;
constexpr int NPAD = 6912;
constexpr int OFF_B = 0, OFF_C = 1024, OFF_X = 2048, OFF_Q = 3072, OFF_KV = 4096, OFF_IQ = 4608, OFF_IK = 6656, OFF_IW = 6784;
constexpr int IN_COLS = 6800;
constexpr float EPS = 1e-6f;
constexpr float IWSCALE = 0.02209708691207961f;
constexpr float QSCALE = 0.12751743f;
constexpr int KSPLIT = 16;
constexpr int MODN = 16384;
constexpr int TM = 256;
constexpr int SLOTS = 24576;

constexpr size_t al(size_t x) { return (x + 255) & ~(size_t)255; }
constexpr size_t WS_BAR = 0;
constexpr size_t WS_PART = 65536;
constexpr size_t WS_MOD = WS_PART + al((size_t)KSPLIT * 4 * MODN * 4);
constexpr size_t WS_H16 = WS_MOD + al((size_t)4 * MODN * 4);
constexpr size_t WS_WIN16 = WS_H16 + al((size_t)NTOK * D * 2);
constexpr size_t WS_PROJ16 = WS_WIN16 + al((size_t)NPAD * D * 2);
constexpr size_t WS_CKV16 = WS_PROJ16 + al((size_t)NTOK * NPAD * 2);
constexpr size_t WS_QLAT16 = WS_CKV16 + al((size_t)NTOK * 512 * 2);
constexpr size_t WS_SCORE = WS_QLAT16 + al((size_t)NTOK * 4096 * 2);
constexpr size_t WS_SEL = WS_SCORE + al((size_t)NTOK * 2048 * 4);
constexpr size_t WS_NSEL = WS_SEL + al((size_t)NTOK * 256 * 2);
constexpr size_t WS_WOUT16 = WS_NSEL + al((size_t)NTOK * 4);
constexpr size_t WS_WUK16 = WS_WOUT16 + al((size_t)D * D * 2);
constexpr size_t WS_WUV16 = WS_WUK16 + al((size_t)8 * 512 * 128 * 2);
constexpr size_t WS_WR16 = WS_WUV16 + al((size_t)8 * 512 * 128 * 2);
constexpr size_t WS_WGU16 = WS_WR16 + al((size_t)64 * D * 2);
constexpr size_t WS_WD16 = WS_WGU16 + al((size_t)32 * 1024 * D * 2);
constexpr size_t WS_ACT16 = WS_WD16 + al((size_t)32 * D * 512 * 2);
constexpr size_t WS_ROUTE = WS_ACT16 + al((size_t)SLOTS * 512 * 2);
constexpr size_t WS_BLKCNT = WS_ROUTE + al((size_t)NTOK * 32);
constexpr size_t WS_ROWMAP = WS_BLKCNT + al((size_t)256 * 32 * 4);
constexpr size_t WS_CSLOT = WS_ROWMAP + al((size_t)SLOTS * 4);
constexpr size_t WS_META = WS_CSLOT + al((size_t)SLOTS * 4);
constexpr size_t WS_END = WS_META + 4096;
constexpr size_t WS_MIX16 = WS_H16;
constexpr size_t WS_OSAVE = WS_SCORE;
constexpr size_t WS_H2_16 = WS_PROJ16;
constexpr size_t WS_MASK = WS_SEL;
constexpr size_t WS_X1H = WS_SCORE + 33554432;
constexpr size_t WS_OUT2 = WS_PROJ16 + al((size_t)NTOK * D * 2);
constexpr size_t WS_H2S = WS_QLAT16;

constexpr int LDS_MAIN = 156672;
constexpr int LDS_BYTES = LDS_MAIN + 16;

struct Params {
  const float *x, *c, *w_ada, *b_ada, *g_mix, *w_in, *conv_w, *w_uk, *kv_norm_g, *w_uv, *g_conv_out, *g_attn_out, *w_out, *g_ffn,
      *w_rg, *b_rg, *w_re, *b_re, *w_gate, *w_up, *w_down, *w_ada_f, *b_ada_f, *g_final;
  float* out;
  char* ws;
  int ph_lo, ph_hi, sub, pad;
};
struct Route { int e1, e2; float c1, c2; int r1, r2; int pad0, pad1; };

__device__ __forceinline__ float wave_sum(float v) {
#pragma unroll
  for (int o = 32; o >= 1; o >>= 1) v += __shfl_xor(v, o);
  return v;
}
__device__ __forceinline__ float wave_max(float v) {
#pragma unroll
  for (int o = 32; o >= 1; o >>= 1) v = fmaxf(v, __shfl_xor(v, o));
  return v;
}
#define LDS_BARRIER() do { asm volatile("s_waitcnt lgkmcnt(0)" ::: "memory"); __builtin_amdgcn_s_barrier(); asm volatile("" ::: "memory"); } while (0)
__device__ __forceinline__ void wave_lds_sync() { asm volatile("s_waitcnt lgkmcnt(0)" ::: "memory"); }

__device__ void p0_modpart(const Params& p, char* lds, int item) {
  const int tid = threadIdx.x;
  float* cact = (float*)lds;
  f32x4* xch = (f32x4*)(lds + 2048);
  const int cb = item & 15, ks = item >> 4, k0 = ks * 128;
  const int col = cb * 1024 + (tid & 255) * 4, rh = tid >> 8;
  __syncthreads();
  { const int b = tid >> 7, kk = tid & 127; const float v = p.c[b * D + k0 + kk]; cact[tid] = v / (1.0f + __expf(-v)); }
  __syncthreads();
  const float* w; int ld;
  if (col < 12288) { w = p.w_ada + col; ld = 12288; } else { w = p.w_ada_f + (col - 12288); ld = 4096; }
  w += (size_t)(k0 + rh * 64) * ld;
  const float* ca = cact + rh * 64;
  f32x4 a0 = (f32x4){0.f, 0.f, 0.f, 0.f}, a1 = a0, a2 = a0, a3 = a0;
#pragma unroll 16
  for (int kk = 0; kk < 64; ++kk) {
    const f32x4 wv = __builtin_nontemporal_load((const f32x4*)(w + (size_t)kk * ld));
    a0 += wv * ca[kk]; a1 += wv * ca[128 + kk]; a2 += wv * ca[256 + kk]; a3 += wv * ca[384 + kk];
  }
  if (rh) { xch[(tid & 255) * 4 + 0] = a0; xch[(tid & 255) * 4 + 1] = a1; xch[(tid & 255) * 4 + 2] = a2; xch[(tid & 255) * 4 + 3] = a3; }
  __syncthreads();
  if (!rh) {
    float* part = (float*)(p.ws + WS_PART);
    *(f32x4*)(part + (size_t)(ks * 4 + 0) * MODN + col) = a0 + xch[tid * 4 + 0]; *(f32x4*)(part + (size_t)(ks * 4 + 1) * MODN + col) = a1 + xch[tid * 4 + 1];
    *(f32x4*)(part + (size_t)(ks * 4 + 2) * MODN + col) = a2 + xch[tid * 4 + 2]; *(f32x4*)(part + (size_t)(ks * 4 + 3) * MODN + col) = a3 + xch[tid * 4 + 3];
  }
}

template <int MODE>
__device__ __forceinline__ void cvt_wave(const float* src, int ld, int k0, int n0, int nvalid, half_t* dst, int ldd, int drow0, int dstep) {
  const int lane = threadIdx.x & 63, g = lane & 7, nq = lane >> 3;
  f32x4 v[2][8];
  const int n = n0 + 4 * nq;
#pragma unroll
  for (int tl = 0; tl < 2; ++tl)
#pragma unroll
    for (int i = 0; i < 8; ++i) {
      const int kk = 64 * tl + ((MODE == 0) ? (8 * g + i) : (32 * (g >> 2) + 4 * (g & 3) + (i & 3) + 16 * (i >> 2)));
      v[tl][i] = (n < nvalid) ? __builtin_nontemporal_load((const f32x4*)(src + (size_t)(k0 + kk) * ld + n)) : (f32x4){0.f, 0.f, 0.f, 0.f};
    }
#pragma unroll
  for (int tl = 0; tl < 2; ++tl) {
    half8 o0, o1, o2, o3;
#pragma unroll
    for (int i = 0; i < 8; ++i) { o0[i] = (half_t)v[tl][i][0]; o1[i] = (half_t)v[tl][i][1]; o2[i] = (half_t)v[tl][i][2]; o3[i] = (half_t)v[tl][i][3]; }
    half_t* d = dst + (size_t)(drow0 + 4 * nq * dstep) * ldd + k0 + 64 * tl + 8 * g;
    *(half8*)(d) = o0; *(half8*)(d + (size_t)dstep * ldd) = o1; *(half8*)(d + (size_t)2 * dstep * ldd) = o2; *(half8*)(d + (size_t)3 * dstep * ldd) = o3;
  }
}
constexpr int CV_WIN = 432, CV_WOUT = CV_WIN + 128, CV_WUV = CV_WOUT + 16, CV_WUK = CV_WUV + 128, CV_WR = CV_WUK + 32, CV_GU = CV_WR + 2048, CV_DN = CV_GU + 1024;
__device__ void p0_convert(const Params& p, int it) {
  const int tid = threadIdx.x, wid = tid >> 6;
  if (it < CV_WIN) { const int kt = it & 15, nb = it >> 4;
    cvt_wave<0>(p.w_in, IN_COLS, kt * 128, nb * 256 + wid * 32, IN_COLS, (half_t*)(p.ws + WS_WIN16), D, nb * 256 + wid * 32, 1); return; }
  if (it < CV_WOUT) { const int r = it - CV_WIN, kt = r & 15, nb = r >> 4;
    cvt_wave<0>(p.w_out, D, kt * 128, nb * 256 + wid * 32, D, (half_t*)(p.ws + WS_WOUT16), D, nb * 256 + wid * 32, 1); return; }
  if (it < CV_WUV) { const int r = it - CV_WOUT, h = r >> 1, kt = (r & 1) * 2 + (wid >> 2), nt = wid & 3;
    cvt_wave<1>(p.w_uv + (size_t)h * 512 * 128, 128, kt * 128, nt * 32, 128, (half_t*)(p.ws + WS_WUV16) + (size_t)h * 128 * 512, 512, nt * 32, 1); return; }
  if (it < CV_WUK) { const int r = it - CV_WUV; const size_t e0 = (size_t)r * 4096 + tid * 8; const float* s = p.w_uk + e0;
    const float4 a = *(const float4*)s, b = *(const float4*)(s + 4);
    half8 o; o[0] = (half_t)a.x; o[1] = (half_t)a.y; o[2] = (half_t)a.z; o[3] = (half_t)a.w; o[4] = (half_t)b.x; o[5] = (half_t)b.y; o[6] = (half_t)b.z; o[7] = (half_t)b.w;
    *(half8*)((half_t*)(p.ws + WS_WUK16) + e0) = o; return; }
  if (it < CV_WR) { const int r = it - CV_WUK; const int e0 = r * 4096 + tid * 8; const int n = e0 >> 11, k0 = e0 & 2047;
    half8 o;
#pragma unroll
    for (int e = 0; e < 8; ++e) { float v = 0.f; if (n < 4) v = p.w_rg[(k0 + e) * 4 + n]; else if (n < 36) v = p.w_re[(k0 + e) * 32 + (n - 4)]; o[e] = (half_t)v; }
    *(half8*)((half_t*)(p.ws + WS_WR16) + e0) = o; return; }
  if (it < CV_GU) { const int r = it - CV_WR, e = r >> 6, kt = (r >> 2) & 15, which = (r >> 1) & 1, jb = r & 1;
    const float* s = (which ? p.w_up : p.w_gate) + (size_t)e * D * 512; const int j0 = jb * 256 + wid * 32;
    cvt_wave<0>(s, 512, kt * 128, j0, 512, (half_t*)(p.ws + WS_WGU16) + (size_t)e * 1024 * D, D, 2 * j0 + which, 2); return; }
  { const int r = it - CV_GU, e = r >> 5, kt = (r >> 3) & 3, nb = r & 7;
    cvt_wave<0>(p.w_down + (size_t)e * 512 * D, D, kt * 128, nb * 256 + wid * 32, D, (half_t*)(p.ws + WS_WD16) + (size_t)e * D * 512, 512, nb * 256 + wid * 32, 1); }
}
__device__ void phase0(const Params& p, char* lds) {
  for (int it = blockIdx.x; it < 256; it += gridDim.x) p0_modpart(p, lds, it);
  for (int it = blockIdx.x; it < CV_WR; it += gridDim.x) p0_convert(p, it);
}

__device__ __forceinline__ float modsum(const Params& p, int b, int c) {
  const float* part = (const float*)(p.ws + WS_PART);
  float s = (c < 12288) ? p.b_ada[c] : p.b_ada_f[c - 12288];
#pragma unroll
  for (int ks = 0; ks < KSPLIT; ++ks) s += part[(size_t)(ks * 4 + b) * MODN + c];
  return s;
}
__device__ void phase1(const Params& p, char* lds) {
  const int tid = threadIdx.x, lane = tid & 63, wid = tid >> 6;
  float* s1 = (float*)lds; float* sh1 = s1 + D;
  float* modf = (float*)(p.ws + WS_MOD);
  half_t* h16 = (half_t*)(p.ws + WS_H16);
  for (int rg = blockIdx.x; rg < 256; rg += gridDim.x) {
    const int b = rg >> 6;
    if (tid < 256) { const int idx = rg * 256 + tid; modf[idx] = modsum(p, idx >> 14, idx & (MODN - 1)); }
    for (int c = tid; c < D; c += NT) { const float sc = modsum(p, b, D + c), sh = modsum(p, b, c); s1[c] = p.g_mix[c] * (1.0f + sc); sh1[c] = sh; }
    __syncthreads();
    for (int i = 0; i < 4; ++i) {
      const int t = rg * 32 + wid * 4 + i;
      const float* xr = p.x + (size_t)t * D;
      float4 v[4][2]; float ss = 0.f;
#pragma unroll
      for (int j = 0; j < 4; ++j) { const int c = lane * 8 + 512 * j; v[j][0] = *(const float4*)(xr + c); v[j][1] = *(const float4*)(xr + c + 4);
        ss += v[j][0].x * v[j][0].x + v[j][0].y * v[j][0].y + v[j][0].z * v[j][0].z + v[j][0].w * v[j][0].w + v[j][1].x * v[j][1].x + v[j][1].y * v[j][1].y + v[j][1].z * v[j][1].z + v[j][1].w * v[j][1].w; }
      ss = wave_sum(ss);
      const float rstd = rsqrtf(ss * (1.0f / D) + EPS);
#pragma unroll
      for (int j = 0; j < 4; ++j) { const int c = lane * 8 + 512 * j; const float xv[8] = {v[j][0].x, v[j][0].y, v[j][0].z, v[j][0].w, v[j][1].x, v[j][1].y, v[j][1].z, v[j][1].w};
        half8 o;
#pragma unroll
        for (int e = 0; e < 8; ++e) o[e] = (half_t)(xv[e] * rstd * s1[c + e] + sh1[c + e]);
        *(half8*)(h16 + (size_t)t * D + c) = o; }
    }
    __syncthreads();
  }
}

template <class ARow, class Epi>
__device__ __forceinline__ void sg_tile(char* lds, ARow arow, const half_t* Bt, int ldb, int K, Epi epi) {
  const int tid = threadIdx.x, lane = tid & 63, wid = tid >> 6, wr = wid >> 2, wc = wid & 3, fr = lane & 15, fq = lane >> 4;
  half_t* As = (half_t*)lds; half_t* Bs = As + 128 * 72;
  const int lr = tid >> 3, lc = (tid & 7) * 8;
  const half_t* ap0 = arow(lr) + lc; const half_t* ap1 = arow(lr + 64) + lc;
  const half_t* bp0 = Bt + (size_t)lr * ldb + lc; const half_t* bp1 = Bt + (size_t)(lr + 64) * ldb + lc;
  uint4 ra0 = *(const uint4*)ap0, ra1 = *(const uint4*)ap1, rb0 = *(const uint4*)bp0, rb1 = *(const uint4*)bp1;
  f32x4 acc[4][2];
#pragma unroll
  for (int m = 0; m < 4; ++m)
#pragma unroll
    for (int n = 0; n < 2; ++n) acc[m][n] = (f32x4){0.f, 0.f, 0.f, 0.f};
  for (int k0 = 0; k0 < K; k0 += 64) {
    __syncthreads();
    *(uint4*)(As + lr * 72 + lc) = ra0; *(uint4*)(As + (lr + 64) * 72 + lc) = ra1;
    *(uint4*)(Bs + lr * 72 + lc) = rb0; *(uint4*)(Bs + (lr + 64) * 72 + lc) = rb1;
    __syncthreads();
    if (k0 + 64 < K) { ra0 = *(const uint4*)(ap0 + k0 + 64); ra1 = *(const uint4*)(ap1 + k0 + 64); rb0 = *(const uint4*)(bp0 + k0 + 64); rb1 = *(const uint4*)(bp1 + k0 + 64); }
#pragma unroll
    for (int ks = 0; ks < 2; ++ks) {
      half8 a[4], b[2];
#pragma unroll
      for (int m = 0; m < 4; ++m) a[m] = *(const half8*)(As + (wr * 64 + m * 16 + fr) * 72 + ks * 32 + fq * 8);
#pragma unroll
      for (int n = 0; n < 2; ++n) b[n] = *(const half8*)(Bs + (wc * 32 + n * 16 + fr) * 72 + ks * 32 + fq * 8);
#pragma unroll
      for (int m = 0; m < 4; ++m)
#pragma unroll
        for (int n = 0; n < 2; ++n) acc[m][n] = __builtin_amdgcn_mfma_f32_16x16x32_f16(b[n], a[m], acc[m][n], 0, 0, 0);
    }
  }
#pragma unroll
  for (int m = 0; m < 4; ++m)
#pragma unroll
    for (int n = 0; n < 2; ++n) epi(wr * 64 + m * 16 + fr, wc * 32 + n * 16 + fq * 4, acc[m][n]);
  __syncthreads();
}
__device__ __forceinline__ half4 to_half4(f32x4 v) { half4 o; o[0] = (half_t)v[0]; o[1] = (half_t)v[1]; o[2] = (half_t)v[2]; o[3] = (half_t)v[3]; return o; }


namespace g8 {
constexpr int BM = 256, BK = 64, HALF = 128, HTB = HALF * BK * 2, STAGE_BYTES = 8 * HTB, NXCD = 8, WGM = 8;
__device__ __forceinline__ int lds_byte(int r, int c) { const int st = (r >> 4) * 2 + (c >> 5), rr = r & 15, cc = c & 31, ob = rr * 64 + cc * 2; return st * 1024 + (ob ^ (((ob >> 9) & 1) << 5)); }
__device__ __forceinline__ void stage_rc(int b, int& R, int& C) { const int st = b / 1024, sb = b % 1024, swz = sb ^ (((sb >> 9) & 1) << 5); R = (st >> 1) * 16 + swz / 64; C = (st & 1) * 32 + (swz % 64) / 2; }
__device__ __forceinline__ int perm32(int rho) { const int n = rho >> 4, i = rho & 15; return 8 * (i >> 2) + 4 * n + (i & 3); }
struct Unit { int pm, pn; size_t aoff, boff; };
struct DenseOrder {
  int nM, nN, nwg, G, c; size_t tstep;
  __device__ void init(int M, int N, int K, int G_, int c_) { nM = M / BM; nN = N / BM; nwg = nM * nN; G = G_; c = c_; tstep = (size_t)BM * K * 2; }
  __device__ bool next(int i, Unit& u) const {
    const long L = (long)i * G + c; if (L >= nwg) return false;
    int wgid = (int)L; { const int q = nwg / NXCD, r = nwg % NXCD, xcd = wgid % NXCD, off = wgid / NXCD; wgid = (xcd < r ? xcd * (q + 1) : r * (q + 1) + (xcd - r) * q) + off; }
    const int nig = WGM * nN, gid = wgid / nig, fm = gid * WGM, gsz = (nM - fm) < WGM ? (nM - fm) : WGM;
    u.pm = fm + ((wgid % nig) % gsz); u.pn = (wgid % nig) / gsz; u.aoff = (size_t)u.pm * tstep; u.boff = (size_t)u.pn * tstep; return true;
  }
};
template <class Epi, class Sched>
__device__ __forceinline__ void gemm_phase(LAS unsigned char* lds, const half_t* A, const half_t* Bt, const int K, const int lda, const int ldb, const Sched& S, const Epi& E) {
  const int tid = threadIdx.x, wid = __builtin_amdgcn_readfirstlane(tid >> 6), lane = tid & 63, wr = wid >> 2, wc = wid & 3, fr = lane & 15, fq = lane >> 4;
  const int nt = K / BK;
  unsigned voffA[2], voffB[2];
#pragma unroll
  for (int i = 0; i < 2; ++i) { int R, C; stage_rc(tid * 16 + i * 8192, R, C); const int Rb = Epi::PERM ? ((R & ~31) + perm32(R & 31)) : R;
    voffA[i] = (unsigned)(R * lda + C) * 2u; voffB[i] = (unsigned)(Rb * ldb + C) * 2u; }
  const size_t kstep = (size_t)(BK * 2);
  const size_t hstepA = (size_t)HALF * lda * 2, hstepB = (size_t)HALF * ldb * 2;
  const unsigned ldsw = (unsigned)wid * 1024u;
  const int aoff = lds_byte(wr * 64 + fr, fq * 8), boff = lds_byte(wc * 32 + fr, fq * 8);
#define G8_SA(b, h) (((b) * 2 + (h)) * HTB)
#define G8_SB(b, h) ((4 + (b) * 2 + (h)) * HTB)
#define G8_STAGE(bufoff, gbase, voff) do { _Pragma("unroll") for (int _i = 0; _i < 2; ++_i) \
    __builtin_amdgcn_global_load_lds((const unsigned*)((const char*)(gbase) + (voff)[_i]), (LAS unsigned*)(lds + (bufoff) + ldsw + _i * 8192), 16, 0, 0); } while (0)
#define G8_LDA(dst, b, h) do { _Pragma("unroll") for (int m = 0; m < 4; ++m) _Pragma("unroll") for (int k = 0; k < 2; ++k) dst[m][k] = *(const LAS half8*)(lds + G8_SA(b, h) + aoff + m * 2048 + k * 1024); } while (0)
#define G8_LDB(dst, b, h) do { _Pragma("unroll") for (int n = 0; n < 2; ++n) _Pragma("unroll") for (int k = 0; k < 2; ++k) dst[n][k] = *(const LAS half8*)(lds + G8_SB(b, h) + boff + n * 2048 + k * 1024); } while (0)
#define G8_MMA(ai, bj, At, Bt_) do { __builtin_amdgcn_s_setprio(1); _Pragma("unroll") for (int m = 0; m < 4; ++m) _Pragma("unroll") for (int n = 0; n < 2; ++n) _Pragma("unroll") for (int k = 0; k < 2; ++k) \
    acc[ai][bj][m][n] = __builtin_amdgcn_mfma_f32_16x16x32_f16(Bt_[n][k], At[m][k], acc[ai][bj][m][n], 0, 0, 0); __builtin_amdgcn_s_setprio(0); } while (0)
#define G8_WAIT_V(n) asm volatile("s_waitcnt vmcnt(" #n ")" ::: "memory")
#define G8_WAIT_L(n) asm volatile("s_waitcnt lgkmcnt(" #n ")" ::: "memory")
#define G8_BAR __builtin_amdgcn_s_barrier()
#define G8_SCHED __builtin_amdgcn_sched_barrier(0)
  Unit cur, nxt; int ui = 0;
  if (!S.next(0, cur)) return;
  f32x4 acc[2][2][4][2];
#pragma unroll
  for (int a = 0; a < 2; ++a)
#pragma unroll
    for (int b = 0; b < 2; ++b)
#pragma unroll
      for (int m = 0; m < 4; ++m)
#pragma unroll
        for (int n = 0; n < 2; ++n) acc[a][b][m][n] = (f32x4){0.f, 0.f, 0.f, 0.f};
  half8 At[4][2], B0[2][2], B1[2][2];
  const char* cA = (const char*)A + cur.aoff; const char* cB = (const char*)Bt + cur.boff;
  G8_STAGE(G8_SB(0, 0), cB, voffB); G8_STAGE(G8_SA(0, 0), cA, voffA); G8_STAGE(G8_SB(0, 1), cB + hstepB, voffB); G8_STAGE(G8_SA(0, 1), cA + hstepA, voffA);
  if (wr == 1) G8_BAR;
  G8_WAIT_V(4); G8_BAR;
  G8_STAGE(G8_SB(1, 0), cB + kstep, voffB); G8_STAGE(G8_SA(1, 0), cA + kstep, voffA); G8_STAGE(G8_SB(1, 1), cB + hstepB + kstep, voffB);
  G8_WAIT_V(6); G8_BAR;
  for (;;) {
    const bool has_next = S.next(ui + 1, nxt);
    const char* nA = has_next ? (const char*)A + nxt.aoff : cA; const char* nB = has_next ? (const char*)Bt + nxt.boff : cB;
    for (int t = 0; t < nt; t += 2) {
      const bool last = (t == nt - 2);
      const char* a1 = cA + (size_t)(t + 1) * kstep;
      const char* a2 = last ? nA : cA + (size_t)(t + 2) * kstep; const char* b2 = last ? nB : cB + (size_t)(t + 2) * kstep;
      const char* a3 = a2 + kstep; const char* b3 = b2 + kstep;
      G8_LDB(B0, 0, 0); G8_SCHED; G8_LDA(At, 0, 0); G8_STAGE(G8_SA(1, 1), a1 + hstepA, voffA);
      G8_WAIT_L(8); G8_BAR; G8_WAIT_L(0); G8_MMA(0, 0, At, B0); G8_BAR; G8_SCHED;
      G8_LDB(B1, 0, 1); G8_STAGE(G8_SB(0, 0), b2, voffB);
      G8_BAR; G8_WAIT_L(0); G8_MMA(0, 1, At, B1); G8_BAR;
      G8_LDA(At, 0, 1); G8_STAGE(G8_SA(0, 0), a2, voffA);
      G8_BAR; G8_WAIT_L(0); G8_MMA(1, 0, At, B0); G8_BAR; G8_SCHED;
      G8_STAGE(G8_SB(0, 1), b2 + hstepB, voffB);
      G8_WAIT_V(6); G8_BAR; G8_MMA(1, 1, At, B1); G8_BAR;
      G8_LDB(B0, 1, 0); G8_SCHED; G8_LDA(At, 1, 0); G8_STAGE(G8_SA(0, 1), a2 + hstepA, voffA);
      G8_WAIT_L(8); G8_BAR; G8_WAIT_L(0); G8_MMA(0, 0, At, B0); G8_BAR; G8_SCHED;
      G8_LDB(B1, 1, 1); G8_STAGE(G8_SB(1, 0), b3, voffB);
      G8_BAR; G8_WAIT_L(0); G8_MMA(0, 1, At, B1); G8_BAR;
      G8_LDA(At, 1, 1); G8_STAGE(G8_SA(1, 0), a3, voffA);
      G8_BAR; G8_WAIT_L(0); G8_MMA(1, 0, At, B0); G8_BAR; G8_SCHED;
      G8_STAGE(G8_SB(1, 1), b3 + hstepB, voffB);
      G8_WAIT_V(6); G8_BAR; G8_MMA(1, 1, At, B1); G8_BAR;
    }
    E(acc, cur, wr, wc, fr, fq);
    if (!has_next) break;
#pragma unroll
    for (int a = 0; a < 2; ++a)
#pragma unroll
      for (int b = 0; b < 2; ++b)
#pragma unroll
        for (int m = 0; m < 4; ++m)
#pragma unroll
          for (int n = 0; n < 2; ++n) acc[a][b][m][n] = (f32x4){0.f, 0.f, 0.f, 0.f};
    cur = nxt; cA = nA; cB = nB; ++ui;
  }
  G8_WAIT_V(0);
  if (wr == 0) G8_BAR;
  G8_BAR;
#undef G8_SA
#undef G8_SB
#undef G8_STAGE
#undef G8_LDA
#undef G8_LDB
#undef G8_MMA
#undef G8_WAIT_V
#undef G8_WAIT_L
#undef G8_BAR
#undef G8_SCHED
}
__device__ __forceinline__ half8 pack8(f32x4 a, f32x4 b) { half8 o; o[0] = (half_t)a[0]; o[1] = (half_t)a[1]; o[2] = (half_t)a[2]; o[3] = (half_t)a[3]; o[4] = (half_t)b[0]; o[5] = (half_t)b[1]; o[6] = (half_t)b[2]; o[7] = (half_t)b[3]; return o; }
struct EpiHalf {
  static constexpr bool PERM = true;
  half_t* O; int ldc;
  __device__ __forceinline__ void operator()(const f32x4 (&acc)[2][2][4][2], const Unit& u, int wr, int wc, int fr, int fq) const {
    const int row0 = u.pm * BM + wr * 64 + fr, col0 = u.pn * BM + wc * 32 + 8 * fq;
#pragma unroll
    for (int ai = 0; ai < 2; ++ai)
#pragma unroll
      for (int m = 0; m < 4; ++m) { half_t* rowp = O + (size_t)(row0 + ai * HALF + m * 16) * ldc + col0;
#pragma unroll
        for (int bj = 0; bj < 2; ++bj) *(half8*)(rowp + bj * HALF) = pack8(acc[ai][bj][m][0], acc[ai][bj][m][1]); }
  }
};
struct EpiQlat {
  static constexpr bool PERM = true;
  half_t* O;
  __device__ __forceinline__ void operator()(const f32x4 (&acc)[2][2][4][2], const Unit& u, int wr, int wc, int fr, int fq) const {
    const int row0 = u.pm * BM + wr * 64 + fr, col0 = u.pn * BM + wc * 32 + 8 * fq;
#pragma unroll
    for (int ai = 0; ai < 2; ++ai)
#pragma unroll
      for (int m = 0; m < 4; ++m) { half_t* rowp = O + (size_t)(row0 + ai * HALF + m * 16) * 4096 + col0;
#pragma unroll
        for (int bj = 0; bj < 2; ++bj) *(half8*)(rowp + bj * HALF) = pack8(acc[ai][bj][m][0] * QSCALE, acc[ai][bj][m][1] * QSCALE); }
  }
};
struct EpiResid {
  static constexpr bool PERM = true;
  const float* x; const float* modf; half_t* x1;
  __device__ __forceinline__ void operator()(const f32x4 (&acc)[2][2][4][2], const Unit& u, int wr, int wc, int fr, int fq) const {
    const int row0 = u.pm * BM + wr * 64 + fr, col0 = u.pn * BM + wc * 32 + 8 * fq;
#pragma unroll
    for (int ai = 0; ai < 2; ++ai)
#pragma unroll
      for (int m = 0; m < 4; ++m) { const int t = row0 + ai * HALF + m * 16, b = t >> 11;
#pragma unroll
        for (int bj = 0; bj < 2; ++bj) { const int c = col0 + bj * HALF;
          const f32x4 xa = *(const f32x4*)(x + (size_t)t * D + c), xb = *(const f32x4*)(x + (size_t)t * D + c + 4);
          const f32x4 ga = *(const f32x4*)(modf + b * MODN + 4096 + c), gb = *(const f32x4*)(modf + b * MODN + 4096 + c + 4);
          *(half8*)(x1 + (size_t)t * D + c) = pack8(xa + ga * acc[ai][bj][m][0], xb + gb * acc[ai][bj][m][1]); } }
  }
};
struct EpiMoe1 {
  static constexpr bool PERM = true;
  half_t* act; const float* cslot;
  __device__ __forceinline__ void operator()(const f32x4 (&acc)[2][2][4][2], const Unit& u, int wr, int wc, int fr, int fq) const {
    const int row0 = u.pm * BM + wr * 64 + fr, col0 = u.pn * BM + wc * 32 + 8 * fq;
#pragma unroll
    for (int ai = 0; ai < 2; ++ai)
#pragma unroll
      for (int m = 0; m < 4; ++m) { const int slot = row0 + ai * HALF + m * 16; const float cw = cslot[slot];
#pragma unroll
        for (int bj = 0; bj < 2; ++bj) { const f32x4 v0 = acc[ai][bj][m][0], v1 = acc[ai][bj][m][1]; half4 o;
          o[0] = (half_t)(v0[0] / (1.0f + __expf(-v0[0])) * v0[1] * cw); o[1] = (half_t)(v0[2] / (1.0f + __expf(-v0[2])) * v0[3] * cw);
          o[2] = (half_t)(v1[0] / (1.0f + __expf(-v1[0])) * v1[1] * cw); o[3] = (half_t)(v1[2] / (1.0f + __expf(-v1[2])) * v1[3] * cw);
          *(half4*)(act + (size_t)slot * 512 + ((col0 + bj * HALF) >> 1)) = o; } }
  }
};
struct EpiMoe2 {
  static constexpr bool PERM = true;
  half_t* out2; const int* rowmap;
  __device__ __forceinline__ void operator()(const f32x4 (&acc)[2][2][4][2], const Unit& u, int wr, int wc, int fr, int fq) const {
    const int row0 = u.pm * BM + wr * 64 + fr, col0 = u.pn * BM + wc * 32 + 8 * fq;
#pragma unroll
    for (int ai = 0; ai < 2; ++ai)
#pragma unroll
      for (int m = 0; m < 4; ++m) { const int rm = rowmap[row0 + ai * HALF + m * 16];
        if (rm >= 0) { half_t* rowp = out2 + (size_t)rm * D + col0;
#pragma unroll
          for (int bj = 0; bj < 2; ++bj) *(half8*)(rowp + bj * HALF) = pack8(acc[ai][bj][m][0], acc[ai][bj][m][1]); } }
  }
};
}

__device__ void phase2(const Params& p, char* lds) {
  g8::DenseOrder S; S.init(NTOK, NPAD, D, gridDim.x, blockIdx.x);
  g8::EpiHalf E{(half_t*)(p.ws + WS_PROJ16), NPAD};
  g8::gemm_phase(( LAS unsigned char*)lds, (const half_t*)(p.ws + WS_H16), (const half_t*)(p.ws + WS_WIN16), D, D, D, S, E);
}

__device__ void index_block(const Params& p, char* lds, int b, int tb) {
  const int tid = threadIdx.x, lane = tid & 63, wid = tid >> 6;
  const half_t* proj = (const half_t*)(p.ws + WS_PROJ16);
  float* score = (float*)(p.ws + WS_SCORE);
  half_t* Bs = (half_t*)lds;
  const int t0 = b * SEQ + tb * 16;
  const int r = lane & 31, tokb = (r >> 2) & 1, head = (r & 3) + 4 * (r >> 3), kb = lane >> 5;
  half8 af[8];
  { const half_t* src = proj + (size_t)(t0 + 2 * wid + tokb) * NPAD + OFF_IQ + head * 128 + kb * 8;
#pragma unroll
    for (int ks = 0; ks < 8; ++ks) af[ks] = *(const half8*)(src + ks * 16); }
  float wgt[16];
  { const half_t* ws = proj + (size_t)(t0 + 2 * wid + kb) * NPAD + OFF_IW; const half8 w0 = *(const half8*)ws, w1 = *(const half8*)(ws + 8);
#pragma unroll
    for (int e = 0; e < 8; ++e) { wgt[e] = (float)w0[e] * IWSCALE; wgt[8 + e] = (float)w1[e] * IWSCALE; } }
  const int nkt = (tb * 16 + 15) / 128 + 1;
  const int lrow = tid >> 4, lc = (tid & 15) * 8;
  const half_t* bsrc = proj + (size_t)(b * SEQ + lrow) * NPAD + OFF_IK + lc;
  u32x4 rb[4];
#pragma unroll
  for (int i = 0; i < 4; ++i) rb[i] = *(const u32x4*)(bsrc + (size_t)(32 * i) * NPAD);
  LDS_BARRIER();
#pragma unroll
  for (int i = 0; i < 4; ++i) *(u32x4*)(Bs + (lrow + 32 * i) * 136 + lc) = rb[i];
  LDS_BARRIER();
  for (int kt = 0; kt < nkt; ++kt) {
    if (kt + 1 < nkt) {
#pragma unroll
      for (int i = 0; i < 4; ++i) rb[i] = *(const u32x4*)(bsrc + (size_t)((kt + 1) * 128 + 32 * i) * NPAD);
    }
    const half_t* bt = Bs + (kt & 1) * (128 * 136);
#pragma unroll
    for (int sub = 0; sub < 4; ++sub) {
      f32x16 acc;
#pragma unroll
      for (int i = 0; i < 16; ++i) acc[i] = 0.f;
#pragma unroll
      for (int ks = 0; ks < 8; ++ks) { const half8 bf = *(const half8*)(bt + (sub * 32 + (lane & 31)) * 136 + ks * 16 + kb * 8); acc = __builtin_amdgcn_mfma_f32_32x32x16_f16(af[ks], bf, acc, 0, 0, 0); }
      float s = 0.f;
#pragma unroll
      for (int i = 0; i < 16; ++i) s += fmaxf(acc[i], 0.f) * wgt[i];
      score[(size_t)(t0 + 2 * wid + kb) * SEQ + kt * 128 + sub * 32 + (lane & 31)] = s;
    }
    if (kt + 1 < nkt) {
#pragma unroll
      for (int i = 0; i < 4; ++i) *(u32x4*)(Bs + ((kt + 1) & 1) * (128 * 136) + (lrow + 32 * i) * 136 + lc) = rb[i];
    }
    LDS_BARRIER();
  }
}
__device__ __forceinline__ unsigned sortable(float f) { const unsigned u = __float_as_uint(f); return (u & 0x80000000u) ? ~u : (u | 0x80000000u); }
template <int JN> __device__ __forceinline__ int wave_count_ge(const float (&s)[JN], float cand) {
  int cnt = 0;
#pragma unroll
  for (int j = 0; j < JN; ++j) cnt += (s[j] >= cand) ? 1 : 0;
  int tot = 0;
#pragma unroll
  for (int b = 0; b < 6; ++b) tot += __popcll(__ballot((cnt >> b) & 1)) << b;
  return tot;
}
template <int JN> __device__ __forceinline__ void topk_search(const float* sc, unsigned* mask, int pos) {
  const int lane = threadIdx.x & 63, n = pos + 1;
  float s[JN];
#pragma unroll
  for (int j = 0; j < JN; ++j) { const int idx = lane + 64 * j; const float v = __hip_atomic_load(sc + idx, __ATOMIC_RELAXED, __HIP_MEMORY_SCOPE_AGENT); s[j] = (idx <= pos) ? v : -INFINITY; }
  float vmax = -INFINITY, vmin = INFINITY;
#pragma unroll
  for (int j = 0; j < JN; ++j) { vmax = fmaxf(vmax, s[j]); vmin = fminf(vmin, (s[j] == -INFINITY) ? INFINITY : s[j]); }
  vmax = wave_max(vmax); vmin = -wave_max(-vmin);
  float lo = vmin, hi = vmax, thr = 0.f; int cl = n, ch = wave_count_ge<JN>(s, hi); bool found = false;
  if (ch == 256) { found = true; thr = hi; }
  else if (ch < 256) {
    for (int it = 0; it < 80; ++it) {
      float cand = (it < 14) ? (hi - (hi - lo) * ((float)(256 - ch) / (float)(cl - ch))) : 0.5f * (lo + hi);
      if (!(cand > lo && cand < hi)) cand = 0.5f * (lo + hi);
      if (!(cand > lo && cand < hi)) break;
      const int c = wave_count_ge<JN>(s, cand);
      if (c == 256) { found = true; thr = cand; break; }
      if (c > 256) { lo = cand; cl = c; } else { hi = cand; ch = c; }
    }
  }
  const float tv = found ? thr : lo; const int need = found ? 4096 : (256 - ch);
  unsigned long long mine = 0ull; int eqseen = 0;
  const unsigned long long ltmask = (1ull << lane) - 1ull;
#pragma unroll
  for (int j = 0; j < JN; ++j) {
    const bool gt = s[j] > tv, eq = s[j] == tv;
    const unsigned long long meq = __ballot(eq);
    const bool take = gt || (eq && (eqseen + __popcll(meq & ltmask)) < need);
    const unsigned long long ms = __ballot(take);
    if (lane == j) mine = ms;
    eqseen += __popcll(meq);
  }
  if (lane < 32) *(unsigned long long*)(mask + 2 * lane) = mine;
}
__device__ void topk_token(const Params& p, int t, int pos) {
  const int lane = threadIdx.x & 63;
  unsigned* mask = (unsigned*)(p.ws + WS_MASK) + (size_t)t * 64;
  const int n = pos + 1;
  if (n <= 256) {
    const int lo = 32 * lane;
    mask[lane] = (n >= lo + 32) ? 0xFFFFFFFFu : (n > lo ? ((1u << (n - lo)) - 1u) : 0u);
    return;
  }
  const float* sc = (const float*)(p.ws + WS_SCORE) + (size_t)t * SEQ;
  if (pos < 1024) topk_search<16>(sc, mask, pos); else topk_search<32>(sc, mask, pos);
}
__device__ void p3_rows(const Params& p, int t) {
  const int lane = threadIdx.x & 63;
  const half_t* proj = (const half_t*)(p.ws + WS_PROJ16);
  const half_t* pr = proj + (size_t)t * NPAD;
  {
    const half8 v = *(const half8*)(pr + OFF_KV + lane * 8);
    float f[8], ss = 0.f;
#pragma unroll
    for (int e = 0; e < 8; ++e) { f[e] = (float)v[e]; ss += f[e] * f[e]; }
    ss = wave_sum(ss);
    const float rstd = rsqrtf(ss * (1.0f / 512.f) + EPS);
    half8 o;
#pragma unroll
    for (int e = 0; e < 8; ++e) o[e] = (half_t)(f[e] * rstd * p.kv_norm_g[lane * 8 + e]);
    *(half8*)((half_t*)(p.ws + WS_CKV16) + (size_t)t * 512 + lane * 8) = o;
  }
  {
    const int pos = t & (SEQ - 1);
    float y[16], ss = 0.f;
#pragma unroll
    for (int hb = 0; hb < 2; ++hb) {
      const int c = lane * 8 + 512 * hb;
      const half8 bg = *(const half8*)(pr + OFF_B + c);
      const half8 c0 = *(const half8*)(pr + OFF_C + c), x0 = *(const half8*)(pr + OFF_X + c);
      half8 c1 = c0, x1 = x0, c2 = c0, x2 = x0;
      if (pos >= 1) { c1 = *(const half8*)(pr - NPAD + OFF_C + c); x1 = *(const half8*)(pr - NPAD + OFF_X + c); }
      if (pos >= 2) { c2 = *(const half8*)(pr - 2 * NPAD + OFF_C + c); x2 = *(const half8*)(pr - 2 * NPAD + OFF_X + c); }
#pragma unroll
      for (int e = 0; e < 8; ++e) {
        const float u0 = (float)c0[e] * (float)x0[e];
        const float u1 = pos >= 1 ? (float)c1[e] * (float)x1[e] : 0.f;
        const float u2 = pos >= 2 ? (float)c2[e] * (float)x2[e] : 0.f;
        const float cv = p.conv_w[c + e] * u2 + p.conv_w[1024 + c + e] * u1 + p.conv_w[2048 + c + e] * u0;
        const float yy = (float)bg[e] * cv; y[hb * 8 + e] = yy; ss += yy * yy;
      }
    }
    ss = wave_sum(ss);
    const float rstd = rsqrtf(ss * (1.0f / 1024.f) + EPS);
    half_t* mix = (half_t*)(p.ws + WS_MIX16) + (size_t)t * D;
#pragma unroll
    for (int hb = 0; hb < 2; ++hb) { const int c = lane * 8 + 512 * hb; half8 o;
#pragma unroll
      for (int e = 0; e < 8; ++e) o[e] = (half_t)(y[hb * 8 + e] * rstd * p.g_conv_out[c + e]);
      *(half8*)(mix + c) = o; }
  }
}
struct QlatOrder {
  int G, c;
  __device__ bool next(int i, g8::Unit& u) const {
    const int L = i * G + c; if (L >= 512) return false;
    const int pm = L >> 4, pn = L & 15, h = pn >> 1;
    u.pm = pm; u.pn = pn; u.aoff = ((size_t)pm * 256 * NPAD + OFF_Q + h * 128) * 2; u.boff = (size_t)pn * 256 * 128 * 2; return true;
  }
};
__device__ void phase3(const Params& p, char* lds) {
  const int wid = threadIdx.x >> 6, sub = p.sub;
  if (sub == 0 || sub == 1)
  for (int it = blockIdx.x; it < 256; it += gridDim.x) {
    const int b = it >> 6, jp = it & 63;
    for (int half = 0; half < 2; ++half) {
      const int tb = half ? (127 - jp) : jp;
      index_block(p, lds, b, tb);
      __syncthreads();
      for (int hh = 0; hh < 2; ++hh) topk_token(p, b * SEQ + tb * 16 + 2 * wid + hh, tb * 16 + 2 * wid + hh);
      __syncthreads();
    }
  }
  if (sub == 0 || sub == 2)
  {
    QlatOrder S{(int)gridDim.x, (int)blockIdx.x};
    g8::EpiQlat E{(half_t*)(p.ws + WS_QLAT16)};
    __syncthreads();
    g8::gemm_phase((LAS unsigned char*)lds, (const half_t*)(p.ws + WS_PROJ16), (const half_t*)(p.ws + WS_WUK16), 128, NPAD, 128, S, E);
  }
  if (sub == 0 || sub == 3)
  for (int t = blockIdx.x * 8 + wid; t < NTOK; t += gridDim.x * 8) p3_rows(p, t);
}

__device__ __forceinline__ float quad_max(float x) {
  auto r = __builtin_amdgcn_permlane16_swap(__float_as_uint(x), __float_as_uint(x), false, false); x = fmaxf(__uint_as_float(r[0]), __uint_as_float(r[1]));
  auto q = __builtin_amdgcn_permlane32_swap(__float_as_uint(x), __float_as_uint(x), false, false); return fmaxf(__uint_as_float(q[0]), __uint_as_float(q[1])); }
__device__ __forceinline__ float quad_sum(float x) {
  auto r = __builtin_amdgcn_permlane16_swap(__float_as_uint(x), __float_as_uint(x), false, false); x = __uint_as_float(r[0]) + __uint_as_float(r[1]);
  auto q = __builtin_amdgcn_permlane32_swap(__float_as_uint(x), __float_as_uint(x), false, false); return __uint_as_float(q[0]) + __uint_as_float(q[1]); }
__device__ __forceinline__ half8 pack8h(f32x4 a, f32x4 b) { half8 o; o[0] = (half_t)a[0]; o[1] = (half_t)a[1]; o[2] = (half_t)a[2]; o[3] = (half_t)a[3]; o[4] = (half_t)b[0]; o[5] = (half_t)b[1]; o[6] = (half_t)b[2]; o[7] = (half_t)b[3]; return o; }
template <int OFF> __device__ __forceinline__ half4 tr_read(unsigned addr) { half4 r; asm volatile("ds_read_b64_tr_b16 %0, %1 offset:%2" : "=&v"(r) : "v"(addr), "i"(OFF) : "memory"); return r; }
__device__ __forceinline__ void attn_dma_tile(LAS char* L, const half_t* kvb, int kt, int buf, int wid, int lane) {
  const unsigned v0 = (((wid & 1) * 16 + (lane >> 4)) * 1024u) + (wid >> 1) * 256u + 16u * ((lane & 15) ^ ((lane >> 4) << 1));
  const char* tb = (const char*)(kvb + (size_t)kt * 32 * 512);
#pragma unroll
  for (int i = 0; i < 4; ++i)
    __builtin_amdgcn_global_load_lds((const unsigned*)(tb + ((v0 + i * 4096u) ^ (128u * (i & 1)))), (LAS unsigned*)(L + buf * 32768 + (wid * 4 + i) * 1024), 16, 0, 0);
}
template <int STAGE> __device__ __forceinline__ void attn_task(const Params& p, char* lds, int b, int tb, int tb_prev) {
  const int tid = threadIdx.x, lane = tid & 63, wid = __builtin_amdgcn_readfirstlane(tid >> 6), fr = lane & 15, fq = lane >> 4;
  LAS char* L = (LAS char*)lds;
  LAS unsigned* maskl = (LAS unsigned*)(L + 65536);
  const int t0 = b * SEQ + tb * 16;
  const int nkt = ((tb * 16 + 15) >> 5) + 1;
  const half_t* kvb = (const half_t*)(p.ws + WS_CKV16) + (size_t)b * SEQ * 512;
  __syncthreads();
  { const unsigned* mg = (const unsigned*)(p.ws + WS_MASK) + (size_t)t0 * 64; maskl[tid] = mg[tid]; maskl[tid + 512] = mg[tid + 512]; }
  half8 qf[6];
  LAS char* Lq = L + 73728 + wid * 10240 + lane * 16;
  { const half_t* qs = (const half_t*)(p.ws + WS_QLAT16) + (size_t)(t0 + fr) * 4096 + wid * 512 + fq * 8;
#pragma unroll
    for (int s = 0; s < 6; ++s) qf[s] = *(const half8*)(qs + 32 * s);
#pragma unroll
    for (int s = 6; s < 16; ++s) *(LAS half8*)(Lq + (s - 6) * 1024) = *(const half8*)(qs + 32 * s); }
  const unsigned R2 = 256u * fr + ((16u * fq) ^ ((fr & 7u) << 5));
  const unsigned q4 = (lane & 15) >> 2, pp = lane & 3, rowt = 4 * fq + q4;
  const unsigned Rt = (unsigned)(size_t)L + 256u * rowt + ((rowt & 7u) << 5) + 16u * (pp >> 1) + 8u * (pp & 1);
  f32x4 o[32];
#pragma unroll
  for (int n = 0; n < 32; ++n) o[n] = (f32x4){0.f, 0.f, 0.f, 0.f};
  float m = -1e30f, l = 0.f;
  attn_dma_tile(L, kvb, 0, 0, wid, lane);
  asm volatile("s_waitcnt vmcnt(0)" ::: "memory");
  __syncthreads();
  for (int kt = 0; kt < nkt; ++kt) {
    if (kt + 1 < nkt) attn_dma_tile(L, kvb, kt + 1, (kt + 1) & 1, wid, lane);
    const unsigned bo = (kt & 1) * 32768u;
    f32x4 s0 = (f32x4){0.f, 0.f, 0.f, 0.f}, s1 = (f32x4){0.f, 0.f, 0.f, 0.f};
#pragma unroll
    for (int g = 0; g < 4; ++g) {
      half8 ka[4], kb[4], qv[4];
#pragma unroll
      for (int i = 0; i < 4; ++i) { const int s = 4 * g + i; const unsigned ra = (R2 + bo) ^ (64u * i);
        ka[i] = *(const LAS half8*)(L + ra + g * 8192); kb[i] = *(const LAS half8*)(L + ra + g * 8192 + 4096);
        qv[i] = (s < 6) ? qf[s < 6 ? s : 0] : *(const LAS half8*)(Lq + (s - 6) * 1024); }
      __builtin_amdgcn_sched_barrier(0);
#pragma unroll
      for (int i = 0; i < 4; ++i) { s0 = __builtin_amdgcn_mfma_f32_16x16x32_f16(ka[i], qv[i], s0, 0, 0, 0); s1 = __builtin_amdgcn_mfma_f32_16x16x32_f16(kb[i], qv[i], s1, 0, 0, 0); }
      __builtin_amdgcn_sched_barrier(0);
    }
    const unsigned mw = maskl[fr * 64 + kt] >> (4 * fq);
    float sv[8];
#pragma unroll
    for (int r = 0; r < 4; ++r) { sv[r] = ((mw >> r) & 1u) ? s0[r] : -INFINITY; sv[4 + r] = ((mw >> (16 + r)) & 1u) ? s1[r] : -INFINITY; }
    float mt = fmaxf(fmaxf(fmaxf(sv[0], sv[1]), fmaxf(sv[2], sv[3])), fmaxf(fmaxf(sv[4], sv[5]), fmaxf(sv[6], sv[7])));
    mt = quad_max(mt);
    if (__any(mt > m + 8.0f)) {
      const float mn = fmaxf(m, mt), sc = __builtin_amdgcn_exp2f(m - mn);
      l *= sc; m = mn;
#pragma unroll
      for (int n = 0; n < 32; ++n) o[n] *= sc;
    }
    half8 pf; float ps = 0.f;
#pragma unroll
    for (int r = 0; r < 8; ++r) { const float pv = __builtin_amdgcn_exp2f(sv[r] - m); ps += pv; pf[r] = (half_t)pv; }
    l += ps;
asm volatile("s_waitcnt lgkmcnt(0)" ::: "memory"); __builtin_amdgcn_sched_barrier(0);
    const half4 xa0 = tr_read<0>((Rt + bo) ^ 0u), ya0 = tr_read<4096>((Rt + bo) ^ 0u), xb0 = tr_read<0>((Rt + bo) ^ 32u), yb0 = tr_read<4096>((Rt + bo) ^ 32u);
    const half4 xa1 = tr_read<0>((Rt + bo) ^ 64u), ya1 = tr_read<4096>((Rt + bo) ^ 64u), xb1 = tr_read<0>((Rt + bo) ^ 96u), yb1 = tr_read<4096>((Rt + bo) ^ 96u);
    asm volatile("s_waitcnt lgkmcnt(4)" ::: "memory"); __builtin_amdgcn_sched_barrier(0);
    o[0] = __builtin_amdgcn_mfma_f32_16x16x32_f16((half8){xa0[0], xa0[1], xa0[2], xa0[3], ya0[0], ya0[1], ya0[2], ya0[3]}, pf, o[0], 0, 0, 0);
    o[1] = __builtin_amdgcn_mfma_f32_16x16x32_f16((half8){xb0[0], xb0[1], xb0[2], xb0[3], yb0[0], yb0[1], yb0[2], yb0[3]}, pf, o[1], 0, 0, 0);
    __builtin_amdgcn_sched_barrier(0);
    const half4 xa2 = tr_read<0>((Rt + bo) ^ 128u), ya2 = tr_read<4096>((Rt + bo) ^ 128u), xb2 = tr_read<0>((Rt + bo) ^ 160u), yb2 = tr_read<4096>((Rt + bo) ^ 160u);
    asm volatile("s_waitcnt lgkmcnt(4)" ::: "memory"); __builtin_amdgcn_sched_barrier(0);
    o[2] = __builtin_amdgcn_mfma_f32_16x16x32_f16((half8){xa1[0], xa1[1], xa1[2], xa1[3], ya1[0], ya1[1], ya1[2], ya1[3]}, pf, o[2], 0, 0, 0);
    o[3] = __builtin_amdgcn_mfma_f32_16x16x32_f16((half8){xb1[0], xb1[1], xb1[2], xb1[3], yb1[0], yb1[1], yb1[2], yb1[3]}, pf, o[3], 0, 0, 0);
    __builtin_amdgcn_sched_barrier(0);
    const half4 xa3 = tr_read<0>((Rt + bo) ^ 192u), ya3 = tr_read<4096>((Rt + bo) ^ 192u), xb3 = tr_read<0>((Rt + bo) ^ 224u), yb3 = tr_read<4096>((Rt + bo) ^ 224u);
    asm volatile("s_waitcnt lgkmcnt(4)" ::: "memory"); __builtin_amdgcn_sched_barrier(0);
    o[4] = __builtin_amdgcn_mfma_f32_16x16x32_f16((half8){xa2[0], xa2[1], xa2[2], xa2[3], ya2[0], ya2[1], ya2[2], ya2[3]}, pf, o[4], 0, 0, 0);
    o[5] = __builtin_amdgcn_mfma_f32_16x16x32_f16((half8){xb2[0], xb2[1], xb2[2], xb2[3], yb2[0], yb2[1], yb2[2], yb2[3]}, pf, o[5], 0, 0, 0);
    __builtin_amdgcn_sched_barrier(0);
    const half4 xa4 = tr_read<8192>((Rt + bo) ^ 0u), ya4 = tr_read<12288>((Rt + bo) ^ 0u), xb4 = tr_read<8192>((Rt + bo) ^ 32u), yb4 = tr_read<12288>((Rt + bo) ^ 32u);
    asm volatile("s_waitcnt lgkmcnt(4)" ::: "memory"); __builtin_amdgcn_sched_barrier(0);
    o[6] = __builtin_amdgcn_mfma_f32_16x16x32_f16((half8){xa3[0], xa3[1], xa3[2], xa3[3], ya3[0], ya3[1], ya3[2], ya3[3]}, pf, o[6], 0, 0, 0);
    o[7] = __builtin_amdgcn_mfma_f32_16x16x32_f16((half8){xb3[0], xb3[1], xb3[2], xb3[3], yb3[0], yb3[1], yb3[2], yb3[3]}, pf, o[7], 0, 0, 0);
    __builtin_amdgcn_sched_barrier(0);
    const half4 xa5 = tr_read<8192>((Rt + bo) ^ 64u), ya5 = tr_read<12288>((Rt + bo) ^ 64u), xb5 = tr_read<8192>((Rt + bo) ^ 96u), yb5 = tr_read<12288>((Rt + bo) ^ 96u);
    asm volatile("s_waitcnt lgkmcnt(4)" ::: "memory"); __builtin_amdgcn_sched_barrier(0);
    o[8] = __builtin_amdgcn_mfma_f32_16x16x32_f16((half8){xa4[0], xa4[1], xa4[2], xa4[3], ya4[0], ya4[1], ya4[2], ya4[3]}, pf, o[8], 0, 0, 0);
    o[9] = __builtin_amdgcn_mfma_f32_16x16x32_f16((half8){xb4[0], xb4[1], xb4[2], xb4[3], yb4[0], yb4[1], yb4[2], yb4[3]}, pf, o[9], 0, 0, 0);
    __builtin_amdgcn_sched_barrier(0);
    const half4 xa6 = tr_read<8192>((Rt + bo) ^ 128u), ya6 = tr_read<12288>((Rt + bo) ^ 128u), xb6 = tr_read<8192>((Rt + bo) ^ 160u), yb6 = tr_read<12288>((Rt + bo) ^ 160u);
    asm volatile("s_waitcnt lgkmcnt(4)" ::: "memory"); __builtin_amdgcn_sched_barrier(0);
    o[10] = __builtin_amdgcn_mfma_f32_16x16x32_f16((half8){xa5[0], xa5[1], xa5[2], xa5[3], ya5[0], ya5[1], ya5[2], ya5[3]}, pf, o[10], 0, 0, 0);
    o[11] = __builtin_amdgcn_mfma_f32_16x16x32_f16((half8){xb5[0], xb5[1], xb5[2], xb5[3], yb5[0], yb5[1], yb5[2], yb5[3]}, pf, o[11], 0, 0, 0);
    __builtin_amdgcn_sched_barrier(0);
    const half4 xa7 = tr_read<8192>((Rt + bo) ^ 192u), ya7 = tr_read<12288>((Rt + bo) ^ 192u), xb7 = tr_read<8192>((Rt + bo) ^ 224u), yb7 = tr_read<12288>((Rt + bo) ^ 224u);
    asm volatile("s_waitcnt lgkmcnt(4)" ::: "memory"); __builtin_amdgcn_sched_barrier(0);
    o[12] = __builtin_amdgcn_mfma_f32_16x16x32_f16((half8){xa6[0], xa6[1], xa6[2], xa6[3], ya6[0], ya6[1], ya6[2], ya6[3]}, pf, o[12], 0, 0, 0);
    o[13] = __builtin_amdgcn_mfma_f32_16x16x32_f16((half8){xb6[0], xb6[1], xb6[2], xb6[3], yb6[0], yb6[1], yb6[2], yb6[3]}, pf, o[13], 0, 0, 0);
    __builtin_amdgcn_sched_barrier(0);
    const half4 xa8 = tr_read<16384>((Rt + bo) ^ 0u), ya8 = tr_read<20480>((Rt + bo) ^ 0u), xb8 = tr_read<16384>((Rt + bo) ^ 32u), yb8 = tr_read<20480>((Rt + bo) ^ 32u);
    asm volatile("s_waitcnt lgkmcnt(4)" ::: "memory"); __builtin_amdgcn_sched_barrier(0);
    o[14] = __builtin_amdgcn_mfma_f32_16x16x32_f16((half8){xa7[0], xa7[1], xa7[2], xa7[3], ya7[0], ya7[1], ya7[2], ya7[3]}, pf, o[14], 0, 0, 0);
    o[15] = __builtin_amdgcn_mfma_f32_16x16x32_f16((half8){xb7[0], xb7[1], xb7[2], xb7[3], yb7[0], yb7[1], yb7[2], yb7[3]}, pf, o[15], 0, 0, 0);
    __builtin_amdgcn_sched_barrier(0);
    const half4 xa9 = tr_read<16384>((Rt + bo) ^ 64u), ya9 = tr_read<20480>((Rt + bo) ^ 64u), xb9 = tr_read<16384>((Rt + bo) ^ 96u), yb9 = tr_read<20480>((Rt + bo) ^ 96u);
    asm volatile("s_waitcnt lgkmcnt(4)" ::: "memory"); __builtin_amdgcn_sched_barrier(0);
    o[16] = __builtin_amdgcn_mfma_f32_16x16x32_f16((half8){xa8[0], xa8[1], xa8[2], xa8[3], ya8[0], ya8[1], ya8[2], ya8[3]}, pf, o[16], 0, 0, 0);
    o[17] = __builtin_amdgcn_mfma_f32_16x16x32_f16((half8){xb8[0], xb8[1], xb8[2], xb8[3], yb8[0], yb8[1], yb8[2], yb8[3]}, pf, o[17], 0, 0, 0);
    __builtin_amdgcn_sched_barrier(0);
    const half4 xa10 = tr_read<16384>((Rt + bo) ^ 128u), ya10 = tr_read<20480>((Rt + bo) ^ 128u), xb10 = tr_read<16384>((Rt + bo) ^ 160u), yb10 = tr_read<20480>((Rt + bo) ^ 160u);
    asm volatile("s_waitcnt lgkmcnt(4)" ::: "memory"); __builtin_amdgcn_sched_barrier(0);
    o[18] = __builtin_amdgcn_mfma_f32_16x16x32_f16((half8){xa9[0], xa9[1], xa9[2], xa9[3], ya9[0], ya9[1], ya9[2], ya9[3]}, pf, o[18], 0, 0, 0);
    o[19] = __builtin_amdgcn_mfma_f32_16x16x32_f16((half8){xb9[0], xb9[1], xb9[2], xb9[3], yb9[0], yb9[1], yb9[2], yb9[3]}, pf, o[19], 0, 0, 0);
    __builtin_amdgcn_sched_barrier(0);
    const half4 xa11 = tr_read<16384>((Rt + bo) ^ 192u), ya11 = tr_read<20480>((Rt + bo) ^ 192u), xb11 = tr_read<16384>((Rt + bo) ^ 224u), yb11 = tr_read<20480>((Rt + bo) ^ 224u);
    asm volatile("s_waitcnt lgkmcnt(4)" ::: "memory"); __builtin_amdgcn_sched_barrier(0);
    o[20] = __builtin_amdgcn_mfma_f32_16x16x32_f16((half8){xa10[0], xa10[1], xa10[2], xa10[3], ya10[0], ya10[1], ya10[2], ya10[3]}, pf, o[20], 0, 0, 0);
    o[21] = __builtin_amdgcn_mfma_f32_16x16x32_f16((half8){xb10[0], xb10[1], xb10[2], xb10[3], yb10[0], yb10[1], yb10[2], yb10[3]}, pf, o[21], 0, 0, 0);
    __builtin_amdgcn_sched_barrier(0);
    const half4 xa12 = tr_read<24576>((Rt + bo) ^ 0u), ya12 = tr_read<28672>((Rt + bo) ^ 0u), xb12 = tr_read<24576>((Rt + bo) ^ 32u), yb12 = tr_read<28672>((Rt + bo) ^ 32u);
    asm volatile("s_waitcnt lgkmcnt(4)" ::: "memory"); __builtin_amdgcn_sched_barrier(0);
    o[22] = __builtin_amdgcn_mfma_f32_16x16x32_f16((half8){xa11[0], xa11[1], xa11[2], xa11[3], ya11[0], ya11[1], ya11[2], ya11[3]}, pf, o[22], 0, 0, 0);
    o[23] = __builtin_amdgcn_mfma_f32_16x16x32_f16((half8){xb11[0], xb11[1], xb11[2], xb11[3], yb11[0], yb11[1], yb11[2], yb11[3]}, pf, o[23], 0, 0, 0);
    __builtin_amdgcn_sched_barrier(0);
    const half4 xa13 = tr_read<24576>((Rt + bo) ^ 64u), ya13 = tr_read<28672>((Rt + bo) ^ 64u), xb13 = tr_read<24576>((Rt + bo) ^ 96u), yb13 = tr_read<28672>((Rt + bo) ^ 96u);
    asm volatile("s_waitcnt lgkmcnt(4)" ::: "memory"); __builtin_amdgcn_sched_barrier(0);
    o[24] = __builtin_amdgcn_mfma_f32_16x16x32_f16((half8){xa12[0], xa12[1], xa12[2], xa12[3], ya12[0], ya12[1], ya12[2], ya12[3]}, pf, o[24], 0, 0, 0);
    o[25] = __builtin_amdgcn_mfma_f32_16x16x32_f16((half8){xb12[0], xb12[1], xb12[2], xb12[3], yb12[0], yb12[1], yb12[2], yb12[3]}, pf, o[25], 0, 0, 0);
    __builtin_amdgcn_sched_barrier(0);
    const half4 xa14 = tr_read<24576>((Rt + bo) ^ 128u), ya14 = tr_read<28672>((Rt + bo) ^ 128u), xb14 = tr_read<24576>((Rt + bo) ^ 160u), yb14 = tr_read<28672>((Rt + bo) ^ 160u);
    asm volatile("s_waitcnt lgkmcnt(4)" ::: "memory"); __builtin_amdgcn_sched_barrier(0);
    o[26] = __builtin_amdgcn_mfma_f32_16x16x32_f16((half8){xa13[0], xa13[1], xa13[2], xa13[3], ya13[0], ya13[1], ya13[2], ya13[3]}, pf, o[26], 0, 0, 0);
    o[27] = __builtin_amdgcn_mfma_f32_16x16x32_f16((half8){xb13[0], xb13[1], xb13[2], xb13[3], yb13[0], yb13[1], yb13[2], yb13[3]}, pf, o[27], 0, 0, 0);
    __builtin_amdgcn_sched_barrier(0);
    const half4 xa15 = tr_read<24576>((Rt + bo) ^ 192u), ya15 = tr_read<28672>((Rt + bo) ^ 192u), xb15 = tr_read<24576>((Rt + bo) ^ 224u), yb15 = tr_read<28672>((Rt + bo) ^ 224u);
    asm volatile("s_waitcnt lgkmcnt(4)" ::: "memory"); __builtin_amdgcn_sched_barrier(0);
    o[28] = __builtin_amdgcn_mfma_f32_16x16x32_f16((half8){xa14[0], xa14[1], xa14[2], xa14[3], ya14[0], ya14[1], ya14[2], ya14[3]}, pf, o[28], 0, 0, 0);
    o[29] = __builtin_amdgcn_mfma_f32_16x16x32_f16((half8){xb14[0], xb14[1], xb14[2], xb14[3], yb14[0], yb14[1], yb14[2], yb14[3]}, pf, o[29], 0, 0, 0);
    __builtin_amdgcn_sched_barrier(0);
    asm volatile("s_waitcnt lgkmcnt(0)" ::: "memory"); __builtin_amdgcn_sched_barrier(0);
    o[30] = __builtin_amdgcn_mfma_f32_16x16x32_f16((half8){xa15[0], xa15[1], xa15[2], xa15[3], ya15[0], ya15[1], ya15[2], ya15[3]}, pf, o[30], 0, 0, 0);
    o[31] = __builtin_amdgcn_mfma_f32_16x16x32_f16((half8){xb15[0], xb15[1], xb15[2], xb15[3], yb15[0], yb15[1], yb15[2], yb15[3]}, pf, o[31], 0, 0, 0);
    __builtin_amdgcn_sched_barrier(0);
    asm volatile("s_waitcnt vmcnt(0)" ::: "memory");
    __syncthreads();
  }
  l = quad_sum(l);
  const float inv = 1.0f / l;
  int lane_e = lane, fr_e = fr, fq_e = fq;
  asm volatile("" : "+v"(lane_e), "+v"(fr_e), "+v"(fq_e));
  half8* osave = (half8*)(p.ws + WS_OSAVE) + ((size_t)(blockIdx.x * 8 + wid) * 16) * 64 + lane_e;
  if (STAGE == 0) {
#pragma unroll
    for (int s = 0; s < 16; ++s) { const f32x4 oa = o[2 * s] * inv, ob = o[2 * s + 1] * inv; osave[s * 64] = pack8h(oa, ob); }
    return;
  }
  half8 of1[16];
#pragma unroll
  for (int s = 0; s < 16; ++s) of1[s] = pack8h(o[2 * s] * inv, o[2 * s + 1] * inv);
  f32x4 y0[8], y1[8];
#pragma unroll
  for (int dt = 0; dt < 8; ++dt) { y0[dt] = (f32x4){0.f, 0.f, 0.f, 0.f}; y1[dt] = (f32x4){0.f, 0.f, 0.f, 0.f}; }
  const half_t* wp = (const half_t*)(p.ws + WS_WUV16) + (size_t)(wid * 128 + fr_e) * 512 + fq_e * 8;
  half8 wa[8], wb[8], oa, ob;
#pragma unroll
  for (int dt = 0; dt < 8; ++dt) wa[dt] = *(const half8*)(wp + (size_t)dt * 16 * 512);
  oa = osave[0];
#pragma unroll
  for (int s = 0; s < 16; s += 2) {
#pragma unroll
    for (int dt = 0; dt < 8; ++dt) wb[dt] = *(const half8*)(wp + (size_t)dt * 16 * 512 + 32 * (s + 1));
    ob = osave[(s + 1) * 64];
    __builtin_amdgcn_sched_barrier(0);
#pragma unroll
    for (int dt = 0; dt < 8; ++dt) { y1[dt] = __builtin_amdgcn_mfma_f32_16x16x32_f16(wa[dt], of1[s], y1[dt], 0, 0, 0); y0[dt] = __builtin_amdgcn_mfma_f32_16x16x32_f16(wa[dt], oa, y0[dt], 0, 0, 0); }
    if (s + 2 < 16) {
#pragma unroll
      for (int dt = 0; dt < 8; ++dt) wa[dt] = *(const half8*)(wp + (size_t)dt * 16 * 512 + 32 * (s + 2));
      oa = osave[(s + 2) * 64];
    }
    __builtin_amdgcn_sched_barrier(0);
#pragma unroll
    for (int dt = 0; dt < 8; ++dt) { y1[dt] = __builtin_amdgcn_mfma_f32_16x16x32_f16(wb[dt], of1[s + 1], y1[dt], 0, 0, 0); y0[dt] = __builtin_amdgcn_mfma_f32_16x16x32_f16(wb[dt], ob, y0[dt], 0, 0, 0); }
  }
  float ss0 = 0.f, ss1 = 0.f;
#pragma unroll
  for (int dt = 0; dt < 8; ++dt) { ss0 += y0[dt][0] * y0[dt][0] + y0[dt][1] * y0[dt][1] + y0[dt][2] * y0[dt][2] + y0[dt][3] * y0[dt][3];
    ss1 += y1[dt][0] * y1[dt][0] + y1[dt][1] * y1[dt][1] + y1[dt][2] * y1[dt][2] + y1[dt][3] * y1[dt][3]; }
  ss0 = quad_sum(ss0); ss1 = quad_sum(ss1);
  LAS float* red = (LAS float*)(L + 65536 + 4096);
  if (fq_e == 0) { red[fr_e * 8 + wid] = ss0; red[128 + fr_e * 8 + wid] = ss1; }
  __syncthreads();
  float tot0 = 0.f, tot1 = 0.f;
#pragma unroll
  for (int w = 0; w < 8; ++w) { tot0 += red[fr_e * 8 + w]; tot1 += red[128 + fr_e * 8 + w]; }
  const float rstd0 = rsqrtf(tot0 * (1.0f / 1024.f) + EPS), rstd1 = rsqrtf(tot1 * (1.0f / 1024.f) + EPS);
  half_t* mp0 = (half_t*)(p.ws + WS_MIX16) + (size_t)(b * SEQ + tb_prev * 16 + fr_e) * D + 1024 + wid * 128 + 4 * fq_e;
  half_t* mp1 = (half_t*)(p.ws + WS_MIX16) + (size_t)(t0 + fr_e) * D + 1024 + wid * 128 + 4 * fq_e;
#pragma unroll
  for (int dt = 0; dt < 8; ++dt) { const float4 g = *(const float4*)(p.g_attn_out + wid * 128 + dt * 16 + 4 * fq_e);
    half4 ov; ov[0] = (half_t)(y0[dt][0] * rstd0 * g.x); ov[1] = (half_t)(y0[dt][1] * rstd0 * g.y); ov[2] = (half_t)(y0[dt][2] * rstd0 * g.z); ov[3] = (half_t)(y0[dt][3] * rstd0 * g.w);
    *(half4*)(mp0 + dt * 16) = ov;
    ov[0] = (half_t)(y1[dt][0] * rstd1 * g.x); ov[1] = (half_t)(y1[dt][1] * rstd1 * g.y); ov[2] = (half_t)(y1[dt][2] * rstd1 * g.z); ov[3] = (half_t)(y1[dt][3] * rstd1 * g.w);
    *(half4*)(mp1 + dt * 16) = ov; }
}
__device__ void phase4(const Params& p, char* lds) {
  for (int it = blockIdx.x; it < 256; it += gridDim.x) {
    const int b = it >> 6, jp = it & 63;
    attn_task<0>(p, lds, b, jp, 0);
    attn_task<1>(p, lds, b, 127 - jp, jp);
  }
}

__device__ void phase6(const Params& p, char* lds) {
  g8::DenseOrder S; S.init(NTOK, D, D, gridDim.x, blockIdx.x);
  g8::EpiResid E{p.x, (const float*)(p.ws + WS_MOD), (half_t*)(p.ws + WS_X1H)};
  g8::gemm_phase((LAS unsigned char*)lds, (const half_t*)(p.ws + WS_MIX16), (const half_t*)(p.ws + WS_WOUT16), D, D, D, S, E);
}

__device__ void phase7(const Params& p, char* lds) {
  const int tid = threadIdx.x, lane = tid & 63, wid = tid >> 6, fr = lane & 15, fq = lane >> 4;
  half_t* tile = (half_t*)lds;
  float* logit = (float*)(lds + 32 * 2056 * 2);
  int* e1s = (int*)(logit + 32 * 48); int* e2s = e1s + 32;
  const float* modf = (const float*)(p.ws + WS_MOD); half_t* h2 = (half_t*)(p.ws + WS_H2_16); const half_t* wr = (const half_t*)(p.ws + WS_WR16);
  Route* route = (Route*)(p.ws + WS_ROUTE); int* blkcnt = (int*)(p.ws + WS_BLKCNT); int* rowmap = (int*)(p.ws + WS_ROWMAP);
  for (int rg = blockIdx.x; rg < 256; rg += gridDim.x) {
    const int t0 = rg * 32, b = t0 >> 11;
    if (tid < 96) rowmap[rg * 96 + tid] = -1;
    f32x4 s2[4][2], h2m[4][2];
#pragma unroll
    for (int j = 0; j < 4; ++j)
#pragma unroll
      for (int h = 0; h < 2; ++h) { const int c = lane * 8 + 512 * j + 4 * h;
        s2[j][h] = *(const f32x4*)(p.g_ffn + c) * (*(const f32x4*)(modf + b * MODN + 8192 + c) + 1.0f); h2m[j][h] = *(const f32x4*)(modf + b * MODN + 6144 + c); }
    for (int i = 0; i < 4; ++i) {
      const int lr = wid * 4 + i, t = t0 + lr;
      const half_t* xr = (const half_t*)(p.ws + WS_X1H) + (size_t)t * D;
      half8 v[4]; float ss = 0.f;
#pragma unroll
      for (int j = 0; j < 4; ++j) { v[j] = *(const half8*)(xr + lane * 8 + 512 * j);
#pragma unroll
        for (int e = 0; e < 8; ++e) ss += (float)v[j][e] * (float)v[j][e]; }
      ss = wave_sum(ss);
      const float rstd = rsqrtf(ss * (1.0f / D) + EPS);
#pragma unroll
      for (int j = 0; j < 4; ++j) { const int c = lane * 8 + 512 * j;
        half8 o;
#pragma unroll
        for (int e = 0; e < 8; ++e) o[e] = (half_t)((float)v[j][e] * rstd * s2[j][e >> 2][e & 3] + h2m[j][e >> 2][e & 3]);
        *(half8*)(tile + lr * 2056 + c) = o; *(half8*)(h2 + (size_t)t * D + c) = o; }
    }
    __syncthreads();
    if (wid < 6) {
      const int m = wid / 3, n = wid % 3; f32x4 acc = (f32x4){0.f, 0.f, 0.f, 0.f};
      const half_t* ap = tile + (m * 16 + fr) * 2056 + fq * 8; const half_t* bp = wr + (size_t)(n * 16 + fr) * D + fq * 8;
#pragma unroll 4
      for (int s = 0; s < 64; ++s) acc = __builtin_amdgcn_mfma_f32_16x16x32_f16(*(const half8*)(ap + s * 32), *(const half8*)(bp + s * 32), acc, 0, 0, 0);
#pragma unroll
      for (int r = 0; r < 4; ++r) logit[(m * 16 + fq * 4 + r) * 48 + n * 16 + fr] = acc[r];
    }
    __syncthreads();
    int e1g = 0, e2g = 0; float c1 = 0.f, c2 = 0.f;
    if (tid < 32) {
      const float* l = logit + tid * 48;
      float gl[4]; int g = 0; float gm = -INFINITY;
#pragma unroll
      for (int i = 0; i < 4; ++i) { gl[i] = l[i] + p.b_rg[i]; if (gl[i] > gm) { gm = gl[i]; g = i; } }
      float gs = 0.f;
#pragma unroll
      for (int i = 0; i < 4; ++i) gs += __expf(gl[i] - gm);
      const float pg = 1.0f / gs;
      float el[8]; int i1 = 0; float m1 = -INFINITY;
#pragma unroll
      for (int i = 0; i < 8; ++i) { el[i] = l[4 + g * 8 + i] + p.b_re[g * 8 + i]; if (el[i] > m1) { m1 = el[i]; i1 = i; } }
      int i2 = 0; float m2 = -INFINITY;
#pragma unroll
      for (int i = 0; i < 8; ++i) if (i != i1 && el[i] > m2) { m2 = el[i]; i2 = i; }
      const float w1 = 1.0f / (1.0f + __expf(m2 - m1)), w2 = 1.0f - w1;
      e1g = g * 8 + i1; e2g = g * 8 + i2; c1 = pg * w1; c2 = pg * w2;
      e1s[tid] = e1g; e2s[tid] = e2g;
    }
    __syncthreads();
    if (tid < 32) {
      int r1 = 0, r2 = 0, cnt = 0;
      for (int r = 0; r < 32; ++r) { const int a = e1s[r], bb = e2s[r];
        if (r < tid) { r1 += (a == e1g || bb == e1g); r2 += (a == e2g || bb == e2g); }
        cnt += (a == tid || bb == tid); }
      Route rt; rt.e1 = e1g; rt.e2 = e2g; rt.c1 = c1; rt.c2 = c2; rt.r1 = r1; rt.r2 = r2; rt.pad0 = 0; rt.pad1 = 0;
      route[t0 + tid] = rt;
      blkcnt[rg * 32 + tid] = cnt;
    }
    __syncthreads();
  }
}

__device__ void phase8(const Params& p, char* lds) {
  const int tid = threadIdx.x;
  int* pre = (int*)lds; int* tot = pre + 32; int* base = tot + 32;
  const int* blkcnt = (const int*)(p.ws + WS_BLKCNT); const Route* route = (const Route*)(p.ws + WS_ROUTE);
  int* rowmap = (int*)(p.ws + WS_ROWMAP); float* cslot = (float*)(p.ws + WS_CSLOT); int* meta = (int*)(p.ws + WS_META);
  for (int rg = blockIdx.x; rg < 256; rg += gridDim.x) {
    if (tid < 32) { int a = 0, s = 0; for (int b = 0; b < 256; ++b) { const int c = blkcnt[b * 32 + tid]; s += c; if (b < rg) a += c; } pre[tid] = a; tot[tid] = s; }
    __syncthreads();
    if (tid == 0) { int run = 0; for (int e = 0; e < 32; ++e) { base[e] = run; run += tot[e]; } base[32] = run; }
    __syncthreads();
    if (tid < 32) {
      const int t = rg * 32 + tid; const Route rt = route[t];
      const int s1 = base[rt.e1] + pre[rt.e1] + rt.r1, s2 = base[rt.e2] + pre[rt.e2] + rt.r2;
      rowmap[s1] = 2 * t; rowmap[s2] = 2 * t + 1; cslot[s1] = rt.c1; cslot[s2] = rt.c2;
      if (rg == 0) { meta[tid] = base[tid]; meta[64 + tid] = tot[tid]; if (tid == 0) meta[32] = base[32]; }
    }
    __syncthreads();
  }
}

__device__ __forceinline__ u32x4 pair16(half4 a, half4 b) {
  typedef unsigned u32x2 __attribute__((ext_vector_type(2)));
  const u32x2 ua = __builtin_bit_cast(u32x2, a), ub = __builtin_bit_cast(u32x2, b);
  auto r0 = __builtin_amdgcn_permlane32_swap(ua[0], ub[0], false, false); auto r1 = __builtin_amdgcn_permlane32_swap(ua[1], ub[1], false, false);
  return (u32x4){r0[0], r1[0], r0[1], r1[1]};
}
template <int MODE, int NM>
__device__ __forceinline__ void moe_consume(const Params& p, LAS char* L, int wid, int lane, int slot0, int nrows, int pass0, int e, int nc) {
  constexpr int K = MODE ? 512 : D, NST = K / 64, LDB = MODE ? D : 512;
  const int wr2 = wid >> 1, wc2 = wid & 1, l31 = lane & 31, lh = lane >> 5;
  const int* rowmap = (const int*)(p.ws + WS_ROWMAP);
  const unsigned n0 = 64 * wc2 + (l31 & ~3);
  const unsigned pb0 = (n0 | ((l31 + (l31 >> 4)) & 3)) * 16u + lh * 2048u, pb1 = ((n0 + 32) | ((l31 + 2 + (l31 >> 4)) & 3)) * 16u + lh * 2048u;
  const unsigned pa0 = (unsigned)(wr2 * 32 + l31) * 128u + 16u * (lh ^ ((l31 >> 1) & 7)), pa1 = pa0 ^ 32u, pa2 = pa0 ^ 64u, pa3 = pa0 ^ 96u;
  const char* pfb = MODE ? (const char*)(p.w_down + (size_t)e * 512 * D + 128 * nc) : (const char*)(((wid >> 1) ? p.w_up : p.w_gate) + (size_t)e * D * 512 + 64 * nc);
  const unsigned pfo = MODE ? (unsigned)(((wid * 64 + lane) >> 2) * (D * 4) + ((wid * 64 + lane) & 3) * 128) : (unsigned)(((((wid & 1) * 64 + lane) >> 1)) * (512 * 4) + (lane & 1) * 128);
  const __amdgpu_buffer_rsrc_t prs = __builtin_amdgcn_make_buffer_rsrc((void*)pfb, (short)0, (int)(K * LDB * 4), 0x00020000);
#define MOE_PF(S) __builtin_amdgcn_raw_ptr_buffer_load_lds(prs, (LAS void*)(L + 155648 + wid * 256), 4, pfo, (S) * (64 * LDB * 4), 0, 0)
  f32x16 acc[5][2];
#pragma unroll
  for (int m = 0; m < 5; ++m)
#pragma unroll
    for (int j = 0; j < 2; ++j)
#pragma unroll
      for (int i = 0; i < 16; ++i) acc[m][j][i] = 0.f;
  half8 a0[NM], a1[NM], b00, b01, b10, b11;
#define MOE_RD(AV, B0, B1, PA, T) do { B0 = *(const LAS half8*)(rB + pb0 + (T) * 4096); B1 = *(const LAS half8*)(rB + pb1 + (T) * 4096); \
    _Pragma("unroll") for (int m = 0; m < NM; ++m) AV[m] = *(const LAS half8*)(rA + (PA) + m * 8192); __builtin_amdgcn_sched_barrier(0); } while (0)
#define MOE_MM(AV, B0, B1) do { _Pragma("unroll") for (int m = 0; m < NM; ++m) { acc[m][0] = __builtin_amdgcn_mfma_f32_32x32x16_f16(B0, AV[m], acc[m][0], 0, 0, 0); \
      acc[m][1] = __builtin_amdgcn_mfma_f32_32x32x16_f16(B1, AV[m], acc[m][1], 0, 0, 0); } __builtin_amdgcn_sched_barrier(0); } while (0)
  LDS_BARRIER();
  const LAS char* rB = L; const LAS char* rA = L + 32768;
  MOE_RD(a0, b00, b01, pa0, 0);
#pragma unroll 1
  for (int s = 0; s < NST; ++s) {
    MOE_RD(a1, b10, b11, pa1, 1); MOE_MM(a0, b00, b01);
    MOE_RD(a0, b00, b01, pa2, 2); MOE_MM(a1, b10, b11);
    MOE_RD(a1, b10, b11, pa3, 3); MOE_MM(a0, b00, b01);
    LDS_BARRIER();
    rB = L + ((s + 1) & 1) * 16384; rA = (rA == L + 32768 + 2 * 40960) ? L + 32768 : rA + 40960;
    if (s + 1 < NST) MOE_RD(a0, b00, b01, pa0, 0);
    MOE_MM(a1, b10, b11);
  }
#undef MOE_RD
#undef MOE_MM
#undef MOE_PF
  float cwv[NM]; int rmv[NM];
#pragma unroll
  for (int m = 0; m < NM; ++m) { int lr = pass0 + (2 * m + wr2) * 32 + l31; if (lr >= nrows) lr = nrows - 1;
    if (MODE == 0) cwv[m] = ((const float*)(p.ws + WS_CSLOT))[slot0 + lr]; else rmv[m] = rowmap[slot0 + lr]; }
#pragma unroll
  for (int m = 0; m < NM; ++m) { const int lr = pass0 + (2 * m + wr2) * 32 + l31; if (lr < nrows) {
    const int slot = slot0 + lr;
    if (MODE == 0) {
      const float cw = cwv[m];
      half_t* ap = (half_t*)(p.ws + WS_ACT16) + (size_t)slot * 512 + 64 * nc + 32 * wc2 + 8 * lh;
#pragma unroll
      for (int pr = 0; pr < 2; ++pr) { half4 oa, ob;
#pragma unroll
        for (int i = 0; i < 4; ++i) { const float g = acc[m][0][pr * 8 + i], u = acc[m][1][pr * 8 + i]; oa[i] = (half_t)(g / (1.0f + __expf(-g)) * u * cw);
          const float g2 = acc[m][0][pr * 8 + 4 + i], u2 = acc[m][1][pr * 8 + 4 + i]; ob[i] = (half_t)(g2 / (1.0f + __expf(-g2)) * u2 * cw); }
        *(u32x4*)(ap + 16 * pr) = pair16(oa, ob); }
    } else {
      half_t* op = (half_t*)(p.ws + WS_OUT2) + (size_t)rmv[m] * D + 128 * nc + 64 * wc2 + 8 * lh;
#pragma unroll
      for (int nb = 0; nb < 2; ++nb)
#pragma unroll
        for (int pr = 0; pr < 2; ++pr) { half4 oa, ob;
#pragma unroll
          for (int i = 0; i < 4; ++i) { oa[i] = (half_t)acc[m][nb][pr * 8 + i]; ob[i] = (half_t)acc[m][nb][pr * 8 + 4 + i]; }
          *(u32x4*)(op + 32 * nb + 16 * pr) = pair16(oa, ob); }
    } } }
}
template <int MODE, int ND>
__device__ __forceinline__ void moe_load_a(const Params& p, LAS char* L, int la, int lane, int slot0, int nrows, int pass0) {
  constexpr int K = MODE ? 512 : D, NST = K / 64;
  const int* rowmap = (const int*)(p.ws + WS_ROWMAP);
  const __amdgpu_buffer_rsrc_t ars = __builtin_amdgcn_make_buffer_rsrc((void*)(p.ws + (MODE ? WS_ACT16 : WS_H2_16)), (short)0, MODE ? (16384 * 512 * 2) : (NTOK * D * 2), 0x00020000);
  const unsigned sc = (unsigned)(lane & 7) ^ (unsigned)((la * 4 + (lane >> 4)) & 7);
  unsigned avo[ND];
#pragma unroll
  for (int i = 0; i < ND; ++i) { int lr = pass0 + 8 * (2 * i + la) + (lane >> 3); if (lr >= nrows) lr = 0; const int slot = slot0 + lr;
    avo[i] = (MODE ? (unsigned)slot * 1024u : (unsigned)(rowmap[slot] >> 1) * (unsigned)(D * 2)) + sc * 16u; }
#define MOE_DMA(S, RA) do { _Pragma("unroll") for (int i = 0; i < ND; ++i) \
    __builtin_amdgcn_raw_ptr_buffer_load_lds(ars, (LAS void*)(L + (RA) + (2 * i + la) * 1024), 16, avo[i], (S) * 128, 0, 0); } while (0)
  MOE_DMA(0, 32768);
  MOE_DMA(1, 32768 + 40960);
  if (ND == 20) asm volatile("s_waitcnt vmcnt(20)" ::: "memory"); else if (ND == 16) asm volatile("s_waitcnt vmcnt(16)" ::: "memory"); else asm volatile("s_waitcnt vmcnt(12)" ::: "memory");
  LDS_BARRIER();
  unsigned rn = 32768 + 2 * 40960;
#pragma unroll 1
  for (int s = 0; s < NST; ++s) {
    if (s + 2 < NST) { MOE_DMA(s + 2, rn); rn = (rn == 32768 + 2 * 40960) ? 32768 : rn + 40960;
      if (ND == 20) asm volatile("s_waitcnt vmcnt(20)" ::: "memory"); else if (ND == 16) asm volatile("s_waitcnt vmcnt(16)" ::: "memory"); else asm volatile("s_waitcnt vmcnt(12)" ::: "memory");
    } else asm volatile("s_waitcnt vmcnt(0)" ::: "memory");
    LDS_BARRIER();
  }
#undef MOE_DMA
}
template <int MODE>
__device__ __forceinline__ void moe_load_b(const Params& p, LAS char* L, int mat, int lane, int e, int nc) {
  constexpr int K = MODE ? 512 : D, NST = K / 64, LDB = MODE ? D : 512;
  const int nq = lane & 15, kql = lane >> 4, c0 = 4 * nq;
  const float* bptr = MODE ? (p.w_down + (size_t)e * 512 * D + 128 * nc + mat * 64) : ((mat ? p.w_up : p.w_gate) + (size_t)e * D * 512 + 64 * nc);
  const __amdgpu_buffer_rsrc_t brs = __builtin_amdgcn_make_buffer_rsrc((void*)bptr, (short)0, (int)(K * LDB * 4 - 1024), 0x00020000);
  const unsigned bvo = (unsigned)(4 * kql * LDB + c0) * 4u;
  const int nl = MODE ? (mat * 64 + c0) : ((c0 >> 5) * 64 + mat * 32 + (c0 & 31));
  const unsigned wl = (kql >> 1) * 2048u + (kql & 1) * 8u + nl * 16u;
  u32x4 X[16], Y[16];
#define MOE_LOADB(V, S) do { _Pragma("unroll") for (int q = 0; q < 16; ++q) V[q] = __builtin_amdgcn_raw_buffer_load_b128(brs, bvo, ((S) * 64 + 16 * (q >> 2) + (q & 3)) * (LDB * 4), 0); } while (0)
#define MOE_STOREB(V, BUF) do { _Pragma("unroll") for (int kg = 0; kg < 4; ++kg) _Pragma("unroll") for (int nn = 0; nn < 4; ++nn) { half4 h; \
      h[0] = (half_t)__uint_as_float(V[kg * 4 + 0][nn]); h[1] = (half_t)__uint_as_float(V[kg * 4 + 1][nn]); h[2] = (half_t)__uint_as_float(V[kg * 4 + 2][nn]); h[3] = (half_t)__uint_as_float(V[kg * 4 + 3][nn]); \
      *(LAS half4*)(L + (BUF) * 16384 + kg * 4096 + wl + ((nn + (nl >> 4)) & 3) * 16) = h; } } while (0)
  MOE_LOADB(X, 0);
  MOE_LOADB(Y, 1);
  MOE_STOREB(X, 0);
  LDS_BARRIER();
#pragma unroll 1
  for (int s = 0; s < NST - 2; s += 2) {
    MOE_LOADB(X, s + 2); MOE_STOREB(Y, 1); LDS_BARRIER();
    MOE_LOADB(Y, s + 3); MOE_STOREB(X, 0); LDS_BARRIER();
  }
  MOE_STOREB(Y, 1); LDS_BARRIER();
  LDS_BARRIER();
#undef MOE_LOADB
#undef MOE_STOREB
}
template <int MODE>
__device__ __forceinline__ void moe_unit(const Params& p, char* lds, int e, int nc, int rh) {
  const int tid = threadIdx.x, lane = tid & 63, wid = __builtin_amdgcn_readfirstlane(tid >> 6);
  const int* meta = (const int*)(p.ws + WS_META);
  const int tot = meta[64 + e], base = meta[e];
  const int Rh = (((tot + 1) >> 1) + 15) & ~15;
  const int r0 = rh ? Rh : 0, r1 = rh ? tot : (Rh < tot ? Rh : tot);
  const int nrows = r1 - r0, slot0 = base + r0;
  LAS char* L = (LAS char*)lds;
  for (int pass0 = 0; pass0 < nrows; pass0 += 320) {
    const int prow = (nrows - pass0 < 320) ? (nrows - pass0) : 320;
    const int MT = (((prow + 31) >> 5) + 1) >> 1;
    LDS_BARRIER();
    if (wid < 4) {
      if (MT == 5) moe_consume<MODE, 5>(p, L, wid, lane, slot0, nrows, pass0, e, nc);
      else if (MT == 4) moe_consume<MODE, 4>(p, L, wid, lane, slot0, nrows, pass0, e, nc);
      else moe_consume<MODE, 3>(p, L, wid, lane, slot0, nrows, pass0, e, nc);
    } else if (wid < 6) {
      if (MT == 5) moe_load_a<MODE, 20>(p, L, wid - 4, lane, slot0, nrows, pass0);
      else if (MT == 4) moe_load_a<MODE, 16>(p, L, wid - 4, lane, slot0, nrows, pass0);
      else moe_load_a<MODE, 12>(p, L, wid - 4, lane, slot0, nrows, pass0);
    } else moe_load_b<MODE>(p, L, wid - 6, lane, e, nc);
  }
}
__device__ __forceinline__ int moe_vblock(const Params& p, char* lds) {
  if (gridDim.x != 256) return -1;
  const unsigned* rk = (const unsigned*)(p.ws + WS_BAR) + XCC_RANK;
  bool ok = true;
#pragma unroll
  for (int j = 0; j < 8; ++j) ok = ok && (__hip_atomic_load(rk + 64 * j, __ATOMIC_RELAXED, __HIP_MEMORY_SCOPE_AGENT) == 32u);
  const volatile LAS unsigned* st = (const volatile LAS unsigned*)(LAS char*)(lds + LDS_MAIN);
  return ok ? (int)(st[2] + 8u * st[3]) : -1;
}
__device__ __forceinline__ const LAS int* moe_rank_experts(const Params& p, char* lds) {
  LAS int* order = (LAS int*)((LAS char*)lds + 155648);
  const int* meta = (const int*)(p.ws + WS_META);
  const int tid = threadIdx.x;
  if (tid < 32) { const int t = meta[64 + tid]; int rank = 0;
    for (int j = 0; j < 32; ++j) { const int tj = meta[64 + j]; rank += (tj > t || (tj == t && j < tid)) ? 1 : 0; }
    order[rank] = tid; }
  __syncthreads();
  return order;
}
__device__ void phase9(const Params& p, char* lds) {
  const int vb = moe_vblock(p, lds);
  const LAS int* order = moe_rank_experts(p, lds);
  for (int r = 0; r * (int)gridDim.x < 512; ++r) {
    const int u = blockIdx.x + r * gridDim.x; if (u >= 512) break;
    int e = u >> 4, nc = (u >> 1) & 7, rh = u & 1;
    if (vb >= 0) { const int x = vb & 7, i = vb >> 3; e = r * 16 + x * 2 + (i >> 4); nc = (i >> 1) & 7; rh = i & 1; }
    e = __builtin_amdgcn_readfirstlane(order[(e & 16) ? 31 - (e & 15) : (e & 15)]);
    moe_unit<0>(p, lds, e, nc, rh);
  }
}
__device__ void phase10(const Params& p, char* lds) {
  const int vb = moe_vblock(p, lds);
  const LAS int* order = moe_rank_experts(p, lds);
  for (int r = 0; r * (int)gridDim.x < 1024; ++r) {
    const int u = blockIdx.x + r * gridDim.x; if (u >= 1024) break;
    int e = u >> 5, nc = (u >> 1) & 15, rh = u & 1;
    if (vb >= 0) { const int x = vb & 7, i = vb >> 3; e = r * 8 + x; nc = i >> 1; rh = i & 1; }
    e = __builtin_amdgcn_readfirstlane(order[(e & 8) ? (e | 7) - (e & 7) : e]);
    moe_unit<1>(p, lds, e, nc, rh);
  }
}

__device__ void phase11(const Params& p, char* lds) {
  const int tid = threadIdx.x, lane = tid & 63, wid = tid >> 6;
  const float* modf = (const float*)(p.ws + WS_MOD); const half_t* out2 = (const half_t*)(p.ws + WS_OUT2); const half_t* x1h = (const half_t*)(p.ws + WS_X1H);
  for (int rg = blockIdx.x; rg < 256; rg += gridDim.x) {
    const int t0 = rg * 32 + wid * 4, b = t0 >> 11;
    f32x4 gt[4][2], sf[4][2], hf[4][2];
#pragma unroll
    for (int j = 0; j < 4; ++j)
#pragma unroll
      for (int h = 0; h < 2; ++h) { const int c = lane * 8 + 512 * j + 4 * h;
        gt[j][h] = *(const f32x4*)(modf + b * MODN + 10240 + c);
        sf[j][h] = *(const f32x4*)(p.g_final + c) * (*(const f32x4*)(modf + b * MODN + 12288 + 2048 + c) + 1.0f);
        hf[j][h] = *(const f32x4*)(modf + b * MODN + 12288 + c); }
    half8 xv[4], m0[4], m1[4];
#pragma unroll
    for (int j = 0; j < 4; ++j) { const int c = lane * 8 + 512 * j; xv[j] = *(const half8*)(x1h + (size_t)t0 * D + c);
      m0[j] = *(const half8*)(out2 + (size_t)(2 * t0) * D + c); m1[j] = *(const half8*)(out2 + (size_t)(2 * t0 + 1) * D + c); }
#pragma unroll
    for (int i = 0; i < 4; ++i) {
      const int t = t0 + i;
      float x2[4][8]; float ss = 0.f;
#pragma unroll
      for (int j = 0; j < 4; ++j)
#pragma unroll
        for (int e = 0; e < 8; ++e) { const float v = (float)xv[j][e] + gt[j][e >> 2][e & 3] * ((float)m0[j][e] + (float)m1[j][e]); x2[j][e] = v; ss += v * v; }
      if (i < 3) {
#pragma unroll
        for (int j = 0; j < 4; ++j) { const int c = lane * 8 + 512 * j; xv[j] = *(const half8*)(x1h + (size_t)(t + 1) * D + c);
          m0[j] = *(const half8*)(out2 + (size_t)(2 * t + 2) * D + c); m1[j] = *(const half8*)(out2 + (size_t)(2 * t + 3) * D + c); }
      }
      ss = wave_sum(ss);
      const float rstd = rsqrtf(ss * (1.0f / D) + EPS);
      float* xr = p.out + (size_t)t * D;
#pragma unroll
      for (int j = 0; j < 4; ++j)
#pragma unroll
        for (int h = 0; h < 2; ++h) { f32x4 o;
#pragma unroll
          for (int e = 0; e < 4; ++e) o[e] = x2[j][4 * h + e] * rstd * sf[j][h][e] + hf[j][h][e];
          *(f32x4*)(xr + lane * 8 + 512 * j + 4 * h) = o; }
    }
  }
}


#define XB_TMO      128
#define XB_XCNT(j)  (256  + 64 * (j))
#define XB_XSUB(j)  (1280 + 64 * (j))
#define XB_XGEN(j)  (2304 + 64 * (j))
#define XB_TOP      3328
#define XB_TOPGEN   3392
#define XCD_BAR_WORDS 3456
#define XB_SPIN_CAP (1u << 25)
__device__ __forceinline__ unsigned xb_ld(unsigned* p) { return __hip_atomic_load(p, __ATOMIC_RELAXED, __HIP_MEMORY_SCOPE_AGENT); }
__device__ __forceinline__ unsigned xb_add(unsigned* p, unsigned v) { return __hip_atomic_fetch_add(p, v, __ATOMIC_RELAXED, __HIP_MEMORY_SCOPE_AGENT); }
__device__ __forceinline__ unsigned xb_xcc_id() { return (unsigned)__builtin_amdgcn_s_getreg((3 << 11) | 20) & 0xFu; }
#define XB_SPIN(cond, bar) do { unsigned _sp = 0; while (cond) { __builtin_amdgcn_s_sleep(1); \
    if ((++_sp & 255u) == 0u) { if (xb_ld(&(bar)[XB_TMO])) break; if (_sp > XB_SPIN_CAP) { atomicAdd(&(bar)[XB_TMO], 1u); break; } } } } while (0)
struct XcdBarrier { unsigned* bar; unsigned x; volatile LAS unsigned* st; };
__device__ __forceinline__ XcdBarrier xcd_barrier_post(unsigned* bar, volatile LAS unsigned* st) {
  XcdBarrier b; b.bar = bar; b.x = xb_xcc_id(); b.st = st;
  if (threadIdx.x == 0) (void)xb_add(&bar[XB_XCNT(b.x)], 1u);
  return b;
}
__device__ __forceinline__ void xcd_barrier_complete(unsigned* bar, unsigned x, unsigned& nloc, unsigned& nx) {
  const unsigned G = gridDim.x * gridDim.y * gridDim.z;
  unsigned sum, cnt, mine, sp = 0u;
  for (;;) {
    sum = 0u; cnt = 0u; mine = 0u;
#pragma unroll
    for (unsigned j = 0; j < 16; ++j) { const unsigned c = xb_ld(&bar[XB_XCNT(j)]); sum += c; cnt += (c > 0u) ? 1u : 0u; mine = (j == x) ? c : mine; }
    if (sum == G) break;
    __builtin_amdgcn_s_sleep(1);
    if ((++sp & 255u) == 0u) { if (xb_ld(&bar[XB_TMO])) break; if (sp > XB_SPIN_CAP) { atomicAdd(&bar[XB_TMO], 1u); break; } }
  }
  nloc = mine > 0u ? mine : 1u; nx = cnt > 0u ? cnt : 1u;
}
__device__ __forceinline__ void xcd_barrier(const XcdBarrier& b) {
  asm volatile("s_waitcnt vmcnt(0)" ::: "memory");
  __syncthreads();
  if (threadIdx.x == 0) {
    unsigned* bar = b.bar;
    __builtin_amdgcn_s_waitcnt(0);
    unsigned nloc = b.st[0], nx = b.st[1];
    if (nloc == 0u) { xcd_barrier_complete(bar, b.x, nloc, nx); b.st[0] = nloc; b.st[1] = nx; }
    const unsigned old = xb_add(&bar[XB_XSUB(b.x)], 1u);
    const unsigned gen = old / nloc;
    if (old + 1u == (gen + 1u) * nloc) {
      __builtin_amdgcn_fence(__ATOMIC_RELEASE, "agent");
      asm volatile("s_waitcnt vmcnt(0)" ::: "memory");
      const unsigned og = xb_add(&bar[XB_TOP], 1u);
      const unsigned tg = og / nx;
      if (og + 1u == (tg + 1u) * nx) xb_add(&bar[XB_TOPGEN], 1u);
      else XB_SPIN(xb_ld(&bar[XB_TOPGEN]) == tg, bar);
      __builtin_amdgcn_fence(__ATOMIC_ACQUIRE, "agent");
      xb_add(&bar[XB_XGEN(b.x)], 1u);
      asm volatile("s_waitcnt vmcnt(0)" ::: "memory");
    } else {
      XB_SPIN(xb_ld(&bar[XB_XGEN(b.x)]) == gen, bar);
      __builtin_amdgcn_fence(__ATOMIC_ACQUIRE, "agent");
      asm volatile("s_waitcnt vmcnt(0)" ::: "memory");
    }
  }
  __syncthreads();
}

__global__ void __launch_bounds__(NT) mega(Params p) {
  extern __shared__ __attribute__((aligned(16))) char smem[];
  volatile LAS unsigned* st = (volatile LAS unsigned*)(LAS char*)(smem + LDS_MAIN);
  if (threadIdx.x < 4) st[threadIdx.x] = 0u;
  __syncthreads();
  XcdBarrier bar = xcd_barrier_post((unsigned*)(p.ws + WS_BAR), st);
  if (threadIdx.x == 0) { st[2] = bar.x; st[3] = xb_add((unsigned*)(p.ws + WS_BAR) + XCC_RANK + 64 * bar.x, 1u); }
  __syncthreads();
  const int lo = p.ph_lo, hi = p.ph_hi;
#define PH(k, call) if (lo <= (k) && (k) < hi) { call; if ((k) + 1 < hi) xcd_barrier(bar); }
  PH(0, phase0(p, smem))
  PH(1, phase1(p, smem))
  PH(2, phase2(p, smem))
  PH(3, phase3(p, smem))
  PH(4, phase4(p, smem))
  PH(6, phase6(p, smem))
  PH(7, phase7(p, smem))
  PH(8, phase8(p, smem))
  PH(9, phase9(p, smem))
  PH(10, phase10(p, smem))
  PH(11, phase11(p, smem))
#undef PH
}

extern "C" void kernel_launch(void* const* d_in, const int* in_sizes, int n_in, void* d_out, int out_size, void* d_ws, size_t ws_size, hipStream_t stream) {
  if (n_in != 24 || ws_size < WS_END) { fprintf(stderr, "kernel_launch: need 24 inputs and %zu bytes of workspace (got %d, %zu)\n", (size_t)WS_END, n_in, ws_size); return; }
  static int grid = 0;
  if (grid == 0) {
    int dev = 0, cus = 0, per_cu = 0;
    (void)hipGetDevice(&dev);
    (void)hipDeviceGetAttribute(&cus, hipDeviceAttributeMultiprocessorCount, dev);
    (void)hipFuncSetAttribute((const void*)mega, hipFuncAttributeMaxDynamicSharedMemorySize, LDS_BYTES);
    (void)hipOccupancyMaxActiveBlocksPerMultiprocessor(&per_cu, (const void*)mega, NT, LDS_BYTES);
    if (per_cu < 1) { fprintf(stderr, "kernel_launch: occupancy query says %d blocks per CU\n", per_cu); grid = -1; return; }
    grid = cus;
  }
  if (grid < 0) return;
  (void)hipMemsetAsync((char*)d_ws + WS_BAR, 0, 32768, stream);
  Params p{};
  const float** pp = (const float**)&p;
  for (int i = 0; i < 24; ++i) pp[i] = (const float*)d_in[i];
  p.out = (float*)d_out; p.ws = (char*)d_ws; p.ph_lo = 0; p.ph_hi = 12;
#ifdef PROBE_PHASE
  {
    p.ph_hi = PROBE_PHASE + 1;
    void* a1[] = {&p};
    (void)hipLaunchCooperativeKernel((const void*)mega, dim3(grid), dim3(NT), a1, LDS_BYTES, stream);
    (void)hipMemsetAsync((char*)d_ws + WS_BAR, 0, 32768, stream);
    p.ph_lo = PROBE_PHASE; p.ph_hi = 12;
  }
#endif
#ifdef PROBE_SUB
  {
    p.ph_hi = 4;
    void* a1[] = {&p};
    (void)hipLaunchCooperativeKernel((const void*)mega, dim3(grid), dim3(NT), a1, LDS_BYTES, stream);
    (void)hipMemsetAsync((char*)d_ws + WS_BAR, 0, 32768, stream);
    p.ph_lo = 3; p.ph_hi = 4; p.sub = PROBE_SUB;
    (void)hipLaunchCooperativeKernel((const void*)mega, dim3(grid), dim3(NT), a1, LDS_BYTES, stream);
    (void)hipMemsetAsync((char*)d_ws + WS_BAR, 0, 32768, stream);
    p.ph_lo = 4; p.ph_hi = 12; p.sub = 0;
  }
#endif
  void* args[] = {&p};
  hipError_t e = hipLaunchCooperativeKernel((const void*)mega, dim3(grid), dim3(NT), args, LDS_BYTES, stream);
  if (e != hipSuccess) fprintf(stderr, "cooperative launch failed: %s (grid %d)\n", hipGetErrorString(e), grid);
}
```

```cpp
#include <hip/hip_runtime.h>
#include <stdint.h>
#include <stdio.h>

typedef _Float16 half_t;
typedef _Float16 half8 __attribute__((ext_vector_type(8)));
typedef _Float16 half4 __attribute__((ext_vector_type(4)));
typedef _Float16 half2v __attribute__((ext_vector_type(2)));
typedef float f32x4 __attribute__((ext_vector_type(4)));
typedef float f32x16 __attribute__((ext_vector_type(16)));
typedef unsigned u32x4 __attribute__((ext_vector_type(4)));

#define NT 512
#define EXP_CNT 6144
#define XCC_RANK 4096
#define LAS __attribute__((address_space(3)))
constexpr int D = 2048, SEQ = 2048, NTOK = 8192;
constexpr int NPAD = 6912;
constexpr int OFF_B = 0, OFF_C = 1024, OFF_X = 2048, OFF_Q = 3072, OFF_KV = 4096, OFF_IQ = 4608, OFF_IK = 6656, OFF_IW = 6784;
constexpr int IN_COLS = 6800;
constexpr float EPS = 1e-6f;
constexpr float IWSCALE = 0.02209708691207961f;
constexpr float QSCALE = 0.12751743f;
constexpr int KSPLIT = 16;
constexpr int MODN = 16384;
constexpr int TM = 256;
constexpr int SLOTS = 24576;

constexpr size_t al(size_t x) { return (x + 255) & ~(size_t)255; }
constexpr size_t WS_BAR = 0;
constexpr size_t WS_PART = 65536;
constexpr size_t WS_MOD = WS_PART + al((size_t)KSPLIT * 4 * MODN * 4);
constexpr size_t WS_H16 = WS_MOD + al((size_t)4 * MODN * 4);
constexpr size_t WS_WIN16 = WS_H16 + al((size_t)NTOK * D * 2);
constexpr size_t WS_PROJ16 = WS_WIN16 + al((size_t)NPAD * D * 2);
constexpr size_t WS_CKV16 = WS_PROJ16 + al((size_t)NTOK * NPAD * 2);
constexpr size_t WS_QLAT16 = WS_CKV16 + al((size_t)NTOK * 512 * 2);
constexpr size_t WS_SCORE = WS_QLAT16 + al((size_t)NTOK * 4096 * 2);
constexpr size_t WS_SEL = WS_SCORE + al((size_t)NTOK * 2048 * 4);
constexpr size_t WS_NSEL = WS_SEL + al((size_t)NTOK * 256 * 2);
constexpr size_t WS_WOUT16 = WS_NSEL + al((size_t)NTOK * 4);
constexpr size_t WS_WUK16 = WS_WOUT16 + al((size_t)D * D * 2);
constexpr size_t WS_WUV16 = WS_WUK16 + al((size_t)8 * 512 * 128 * 2);
constexpr size_t WS_WR16 = WS_WUV16 + al((size_t)8 * 512 * 128 * 2);
constexpr size_t WS_WGU16 = WS_WR16 + al((size_t)64 * D * 2);
constexpr size_t WS_WD16 = WS_WGU16 + al((size_t)32 * 1024 * D * 2);
constexpr size_t WS_ACT16 = WS_WD16 + al((size_t)32 * D * 512 * 2);
constexpr size_t WS_ROUTE = WS_ACT16 + al((size_t)SLOTS * 512 * 2);
constexpr size_t WS_BLKCNT = WS_ROUTE + al((size_t)NTOK * 32);
constexpr size_t WS_ROWMAP = WS_BLKCNT + al((size_t)256 * 32 * 4);
constexpr size_t WS_CSLOT = WS_ROWMAP + al((size_t)SLOTS * 4);
constexpr size_t WS_META = WS_CSLOT + al((size_t)SLOTS * 4);
constexpr size_t WS_END = WS_META + 4096;
constexpr size_t WS_MIX16 = WS_H16;
constexpr size_t WS_OSAVE = WS_SCORE;
constexpr size_t WS_H2_16 = WS_PROJ16;
constexpr size_t WS_MASK = WS_SEL;
constexpr size_t WS_RM2 = WS_SEL;
constexpr size_t WS_CS2 = WS_SEL + 1048576;
constexpr size_t WS_X1H = WS_SCORE + 33554432;
constexpr size_t WS_OUT2 = WS_PROJ16 + al((size_t)NTOK * D * 2);
constexpr size_t WS_H2S = WS_QLAT16;

constexpr int LDS_MAIN = 156672;
constexpr int LDS_BYTES = LDS_MAIN + 16;

struct Params {
  const float *x, *c, *w_ada, *b_ada, *g_mix, *w_in, *conv_w, *w_uk, *kv_norm_g, *w_uv, *g_conv_out, *g_attn_out, *w_out, *g_ffn,
      *w_rg, *b_rg, *w_re, *b_re, *w_gate, *w_up, *w_down, *w_ada_f, *b_ada_f, *g_final;
  float* out;
  char* ws;
  int ph_lo, ph_hi, sub, pad;
};
struct Route { int e1, e2; float c1, c2; int r1, r2; int pad0, pad1; };

__device__ __forceinline__ float wave_sum(float v) {
#pragma unroll
  for (int o = 32; o >= 1; o >>= 1) v += __shfl_xor(v, o);
  return v;
}
__device__ __forceinline__ float wave_max(float v) {
#pragma unroll
  for (int o = 32; o >= 1; o >>= 1) v = fmaxf(v, __shfl_xor(v, o));
  return v;
}
#define LDS_BARRIER() do { asm volatile("s_waitcnt lgkmcnt(0)" ::: "memory"); __builtin_amdgcn_s_barrier(); asm volatile("" ::: "memory"); } while (0)
__device__ __forceinline__ void wave_lds_sync() { asm volatile("s_waitcnt lgkmcnt(0)" ::: "memory"); }

__device__ void p0_modpart(const Params& p, char* lds, int item) {
  const int tid = threadIdx.x;
  float* cact = (float*)lds;
  f32x4* xch = (f32x4*)(lds + 2048);
  const int cb = item & 15, ks = item >> 4, k0 = ks * 128;
  const int col = cb * 1024 + (tid & 255) * 4, rh = tid >> 8;
  __syncthreads();
  { const int b = tid >> 7, kk = tid & 127; const float v = p.c[b * D + k0 + kk]; cact[tid] = v / (1.0f + __expf(-v)); }
  __syncthreads();
  const float* w; int ld;
  if (col < 12288) { w = p.w_ada + col; ld = 12288; } else { w = p.w_ada_f + (col - 12288); ld = 4096; }
  w += (size_t)(k0 + rh * 64) * ld;
  const float* ca = cact + rh * 64;
  f32x4 a0 = (f32x4){0.f, 0.f, 0.f, 0.f}, a1 = a0, a2 = a0, a3 = a0;
#pragma unroll 16
  for (int kk = 0; kk < 64; ++kk) {
    const f32x4 wv = __builtin_nontemporal_load((const f32x4*)(w + (size_t)kk * ld));
    a0 += wv * ca[kk]; a1 += wv * ca[128 + kk]; a2 += wv * ca[256 + kk]; a3 += wv * ca[384 + kk];
  }
  if (rh) { xch[(tid & 255) * 4 + 0] = a0; xch[(tid & 255) * 4 + 1] = a1; xch[(tid & 255) * 4 + 2] = a2; xch[(tid & 255) * 4 + 3] = a3; }
  __syncthreads();
  if (!rh) {
    float* part = (float*)(p.ws + WS_PART);
    *(f32x4*)(part + (size_t)(ks * 4 + 0) * MODN + col) = a0 + xch[tid * 4 + 0]; *(f32x4*)(part + (size_t)(ks * 4 + 1) * MODN + col) = a1 + xch[tid * 4 + 1];
    *(f32x4*)(part + (size_t)(ks * 4 + 2) * MODN + col) = a2 + xch[tid * 4 + 2]; *(f32x4*)(part + (size_t)(ks * 4 + 3) * MODN + col) = a3 + xch[tid * 4 + 3];
  }
}

template <int MODE>
__device__ __forceinline__ void cvt_wave(const float* src, int ld, int k0, int n0, int nvalid, half_t* dst, int ldd, int drow0, int dstep) {
  const int lane = threadIdx.x & 63, g = lane & 7, nq = lane >> 3;
  f32x4 v[2][8];
  const int n = n0 + 4 * nq;
#pragma unroll
  for (int tl = 0; tl < 2; ++tl)
#pragma unroll
    for (int i = 0; i < 8; ++i) {
      const int kk = 64 * tl + ((MODE == 0) ? (8 * g + i) : (32 * (g >> 2) + 4 * (g & 3) + (i & 3) + 16 * (i >> 2)));
      v[tl][i] = (n < nvalid) ? __builtin_nontemporal_load((const f32x4*)(src + (size_t)(k0 + kk) * ld + n)) : (f32x4){0.f, 0.f, 0.f, 0.f};
    }
#pragma unroll
  for (int tl = 0; tl < 2; ++tl) {
    half8 o0, o1, o2, o3;
#pragma unroll
    for (int i = 0; i < 8; ++i) { o0[i] = (half_t)v[tl][i][0]; o1[i] = (half_t)v[tl][i][1]; o2[i] = (half_t)v[tl][i][2]; o3[i] = (half_t)v[tl][i][3]; }
    half_t* d = dst + (size_t)(drow0 + 4 * nq * dstep) * ldd + k0 + 64 * tl + 8 * g;
    *(half8*)(d) = o0; *(half8*)(d + (size_t)dstep * ldd) = o1; *(half8*)(d + (size_t)2 * dstep * ldd) = o2; *(half8*)(d + (size_t)3 * dstep * ldd) = o3;
  }
}
constexpr int CV_WIN = 432, CV_WOUT = CV_WIN + 128, CV_WUV = CV_WOUT + 16, CV_WUK = CV_WUV + 128, CV_WR = CV_WUK + 32, CV_GU = CV_WR + 2048, CV_DN = CV_GU + 1024;
__device__ void p0_convert(const Params& p, int it) {
  const int tid = threadIdx.x, wid = tid >> 6;
  if (it < CV_WIN) { const int kt = it & 15, nb = it >> 4;
    cvt_wave<0>(p.w_in, IN_COLS, kt * 128, nb * 256 + wid * 32, IN_COLS, (half_t*)(p.ws + WS_WIN16), D, nb * 256 + wid * 32, 1); return; }
  if (it < CV_WOUT) { const int r = it - CV_WIN, kt = r & 15, nb = r >> 4;
    cvt_wave<0>(p.w_out, D, kt * 128, nb * 256 + wid * 32, D, (half_t*)(p.ws + WS_WOUT16), D, nb * 256 + wid * 32, 1); return; }
  if (it < CV_WUV) { const int r = it - CV_WOUT, h = r >> 1, kt = (r & 1) * 2 + (wid >> 2), nt = wid & 3;
    cvt_wave<1>(p.w_uv + (size_t)h * 512 * 128, 128, kt * 128, nt * 32, 128, (half_t*)(p.ws + WS_WUV16) + (size_t)h * 128 * 512, 512, nt * 32, 1); return; }
  if (it < CV_WUK) { const int r = it - CV_WUV; const size_t e0 = (size_t)r * 4096 + tid * 8; const float* s = p.w_uk + e0;
    const float4 a = *(const float4*)s, b = *(const float4*)(s + 4);
    half8 o; o[0] = (half_t)a.x; o[1] = (half_t)a.y; o[2] = (half_t)a.z; o[3] = (half_t)a.w; o[4] = (half_t)b.x; o[5] = (half_t)b.y; o[6] = (half_t)b.z; o[7] = (half_t)b.w;
    *(half8*)((half_t*)(p.ws + WS_WUK16) + e0) = o; return; }
  if (it < CV_WR) { const int r = it - CV_WUK; const int e0 = r * 4096 + tid * 8; const int n = e0 >> 11, k0 = e0 & 2047;
    half8 o;
#pragma unroll
    for (int e = 0; e < 8; ++e) { float v = 0.f; if (n < 4) v = p.w_rg[(k0 + e) * 4 + n]; else if (n < 36) v = p.w_re[(k0 + e) * 32 + (n - 4)]; o[e] = (half_t)v; }
    *(half8*)((half_t*)(p.ws + WS_WR16) + e0) = o; return; }
  if (it < CV_GU) { const int r = it - CV_WR, e = r >> 6, kt = (r >> 2) & 15, which = (r >> 1) & 1, jb = r & 1;
    const float* s = (which ? p.w_up : p.w_gate) + (size_t)e * D * 512; const int j0 = jb * 256 + wid * 32;
    cvt_wave<0>(s, 512, kt * 128, j0, 512, (half_t*)(p.ws + WS_WGU16) + (size_t)e * 1024 * D, D, 2 * j0 + which, 2); return; }
  { const int r = it - CV_GU, e = r >> 5, kt = (r >> 3) & 3, nb = r & 7;
    cvt_wave<0>(p.w_down + (size_t)e * 512 * D, D, kt * 128, nb * 256 + wid * 32, D, (half_t*)(p.ws + WS_WD16) + (size_t)e * D * 512, 512, nb * 256 + wid * 32, 1); }
}
__device__ void p0_modpart_half(const Params& p, char* lds, int ks, int c512) {
  const int tid = threadIdx.x;
  float* cact = (float*)lds;
  f32x4* xch = (f32x4*)(lds + 2048);
  const int k0 = ks * 128, col = c512 * 512 + (tid & 127) * 4, rq = tid >> 7;
  __syncthreads();
  { const int b = tid >> 7, kk = tid & 127; const float v = p.c[b * D + k0 + kk]; cact[tid] = v / (1.0f + __expf(-v)); }
  __syncthreads();
  const float* w; int ld;
  if (col < 12288) { w = p.w_ada + col; ld = 12288; } else { w = p.w_ada_f + (col - 12288); ld = 4096; }
  w += (size_t)(k0 + rq * 32) * ld;
  const float* ca = cact + rq * 32;
  f32x4 a0 = (f32x4){0.f, 0.f, 0.f, 0.f}, a1 = a0, a2 = a0, a3 = a0;
#pragma unroll 16
  for (int kk = 0; kk < 32; ++kk) {
    const f32x4 wv = __builtin_nontemporal_load((const f32x4*)(w + (size_t)kk * ld));
    a0 += wv * ca[kk]; a1 += wv * ca[128 + kk]; a2 += wv * ca[256 + kk]; a3 += wv * ca[384 + kk];
  }
  if (rq) { f32x4* x = xch + ((rq - 1) * 128 + (tid & 127)) * 4; x[0] = a0; x[1] = a1; x[2] = a2; x[3] = a3; }
  __syncthreads();
  if (!rq) {
#pragma unroll
    for (int q = 0; q < 3; ++q) { const f32x4* x = xch + (q * 128 + tid) * 4; a0 += x[0]; a1 += x[1]; a2 += x[2]; a3 += x[3]; }
    float* part = (float*)(p.ws + WS_PART);
    *(f32x4*)(part + (size_t)(ks * 4 + 0) * MODN + col) = a0; *(f32x4*)(part + (size_t)(ks * 4 + 1) * MODN + col) = a1;
    *(f32x4*)(part + (size_t)(ks * 4 + 2) * MODN + col) = a2; *(f32x4*)(part + (size_t)(ks * 4 + 3) * MODN + col) = a3;
  }
}
__device__ __forceinline__ bool defer_mode() { return gridDim.x == 256; }
__device__ void phase0(const Params& p, char* lds) {
  const bool df = defer_mode();
  for (int j = blockIdx.x; j < (df ? 64 : 256); j += gridDim.x) p0_modpart(p, lds, df ? (j >> 2) * 16 + (j & 3) : j);
  const int c0 = df ? (int)blockIdx.x - 64 : (int)blockIdx.x, cs = df ? 192 : (int)gridDim.x, ce = df ? CV_WIN : CV_WR;
  if (c0 >= 0) for (int it = c0; it < ce; it += cs) p0_convert(p, it);
}
__device__ __forceinline__ float modsum(const Params& p, int b, int c) {
  const float* part = (const float*)(p.ws + WS_PART);
  float s = (c < 12288) ? p.b_ada[c] : p.b_ada_f[c - 12288];
#pragma unroll
  for (int ks = 0; ks < KSPLIT; ++ks) s += part[(size_t)(ks * 4 + b) * MODN + c];
  return s;
}
__device__ void phase1(const Params& p, char* lds) {
  const int tid = threadIdx.x, lane = tid & 63, wid = tid >> 6;
  float* s1 = (float*)lds; float* sh1 = s1 + D;
  float* modf = (float*)(p.ws + WS_MOD);
  half_t* h16 = (half_t*)(p.ws + WS_H16);
  for (int rg = blockIdx.x; rg < 256; rg += gridDim.x) {
    const int b = rg >> 6;
    if (!defer_mode() && tid < 256) { const int idx = rg * 256 + tid; modf[idx] = modsum(p, idx >> 14, idx & (MODN - 1)); }
    for (int c = tid; c < D; c += NT) { const float sc = modsum(p, b, D + c), sh = modsum(p, b, c); s1[c] = p.g_mix[c] * (1.0f + sc); sh1[c] = sh; }
    __syncthreads();
    for (int i = 0; i < 4; ++i) {
      const int t = rg * 32 + wid * 4 + i;
      const float* xr = p.x + (size_t)t * D;
      float4 v[4][2]; float ss = 0.f;
#pragma unroll
      for (int j = 0; j < 4; ++j) { const int c = lane * 8 + 512 * j; v[j][0] = *(const float4*)(xr + c); v[j][1] = *(const float4*)(xr + c + 4);
        ss += v[j][0].x * v[j][0].x + v[j][0].y * v[j][0].y + v[j][0].z * v[j][0].z + v[j][0].w * v[j][0].w + v[j][1].x * v[j][1].x + v[j][1].y * v[j][1].y + v[j][1].z * v[j][1].z + v[j][1].w * v[j][1].w; }
      ss = wave_sum(ss);
      const float rstd = rsqrtf(ss * (1.0f / D) + EPS);
#pragma unroll
      for (int j = 0; j < 4; ++j) { const int c = lane * 8 + 512 * j; const float xv[8] = {v[j][0].x, v[j][0].y, v[j][0].z, v[j][0].w, v[j][1].x, v[j][1].y, v[j][1].z, v[j][1].w};
        half8 o;
#pragma unroll
        for (int e = 0; e < 8; ++e) o[e] = (half_t)(xv[e] * rstd * s1[c + e] + sh1[c + e]);
        *(half8*)(h16 + (size_t)t * D + c) = o; }
    }
    __syncthreads();
  }
}

template <class ARow, class Epi>
__device__ __forceinline__ void sg_tile(char* lds, ARow arow, const half_t* Bt, int ldb, int K, Epi epi) {
  const int tid = threadIdx.x, lane = tid & 63, wid = tid >> 6, wr = wid >> 2, wc = wid & 3, fr = lane & 15, fq = lane >> 4;
  half_t* As = (half_t*)lds; half_t* Bs = As + 128 * 72;
  const int lr = tid >> 3, lc = (tid & 7) * 8;
  const half_t* ap0 = arow(lr) + lc; const half_t* ap1 = arow(lr + 64) + lc;
  const half_t* bp0 = Bt + (size_t)lr * ldb + lc; const half_t* bp1 = Bt + (size_t)(lr + 64) * ldb + lc;
  uint4 ra0 = *(const uint4*)ap0, ra1 = *(const uint4*)ap1, rb0 = *(const uint4*)bp0, rb1 = *(const uint4*)bp1;
  f32x4 acc[4][2];
#pragma unroll
  for (int m = 0; m < 4; ++m)
#pragma unroll
    for (int n = 0; n < 2; ++n) acc[m][n] = (f32x4){0.f, 0.f, 0.f, 0.f};
  for (int k0 = 0; k0 < K; k0 += 64) {
    __syncthreads();
    *(uint4*)(As + lr * 72 + lc) = ra0; *(uint4*)(As + (lr + 64) * 72 + lc) = ra1;
    *(uint4*)(Bs + lr * 72 + lc) = rb0; *(uint4*)(Bs + (lr + 64) * 72 + lc) = rb1;
    __syncthreads();
    if (k0 + 64 < K) { ra0 = *(const uint4*)(ap0 + k0 + 64); ra1 = *(const uint4*)(ap1 + k0 + 64); rb0 = *(const uint4*)(bp0 + k0 + 64); rb1 = *(const uint4*)(bp1 + k0 + 64); }
#pragma unroll
    for (int ks = 0; ks < 2; ++ks) {
      half8 a[4], b[2];
#pragma unroll
      for (int m = 0; m < 4; ++m) a[m] = *(const half8*)(As + (wr * 64 + m * 16 + fr) * 72 + ks * 32 + fq * 8);
#pragma unroll
      for (int n = 0; n < 2; ++n) b[n] = *(const half8*)(Bs + (wc * 32 + n * 16 + fr) * 72 + ks * 32 + fq * 8);
#pragma unroll
      for (int m = 0; m < 4; ++m)
#pragma unroll
        for (int n = 0; n < 2; ++n) acc[m][n] = __builtin_amdgcn_mfma_f32_16x16x32_f16(b[n], a[m], acc[m][n], 0, 0, 0);
    }
  }
#pragma unroll
  for (int m = 0; m < 4; ++m)
#pragma unroll
    for (int n = 0; n < 2; ++n) epi(wr * 64 + m * 16 + fr, wc * 32 + n * 16 + fq * 4, acc[m][n]);
  __syncthreads();
}
__device__ __forceinline__ half4 to_half4(f32x4 v) { half4 o; o[0] = (half_t)v[0]; o[1] = (half_t)v[1]; o[2] = (half_t)v[2]; o[3] = (half_t)v[3]; return o; }


namespace g8 {
constexpr int BM = 256, BK = 64, HALF = 128, HTB = HALF * BK * 2, STAGE_BYTES = 8 * HTB, NXCD = 8, WGM = 8;
__device__ __forceinline__ int lds_byte(int r, int c) { const int st = (r >> 4) * 2 + (c >> 5), rr = r & 15, cc = c & 31, ob = rr * 64 + cc * 2; return st * 1024 + (ob ^ (((ob >> 9) & 1) << 5)); }
__device__ __forceinline__ void stage_rc(int b, int& R, int& C) { const int st = b / 1024, sb = b % 1024, swz = sb ^ (((sb >> 9) & 1) << 5); R = (st >> 1) * 16 + swz / 64; C = (st & 1) * 32 + (swz % 64) / 2; }
__device__ __forceinline__ int perm32(int rho) { const int n = rho >> 4, i = rho & 15; return 8 * (i >> 2) + 4 * n + (i & 3); }
struct Unit { int pm, pn; size_t aoff, boff; };
struct DenseOrder {
  int nM, nN, nwg, G, c; size_t tstep;
  __device__ void init(int M, int N, int K, int G_, int c_) { nM = M / BM; nN = N / BM; nwg = nM * nN; G = G_; c = c_; tstep = (size_t)BM * K * 2; }
  __device__ bool next(int i, Unit& u) const {
    const long L = (long)i * G + c; if (L >= nwg) return false;
    int wgid = (int)L; { const int q = nwg / NXCD, r = nwg % NXCD, xcd = wgid % NXCD, off = wgid / NXCD; wgid = (xcd < r ? xcd * (q + 1) : r * (q + 1) + (xcd - r) * q) + off; }
    const int nig = WGM * nN, gid = wgid / nig, fm = gid * WGM, gsz = (nM - fm) < WGM ? (nM - fm) : WGM;
    u.pm = fm + ((wgid % nig) % gsz); u.pn = (wgid % nig) / gsz; u.aoff = (size_t)u.pm * tstep; u.boff = (size_t)u.pn * tstep; return true;
  }
};
template <class Epi, class Sched>
__device__ __forceinline__ void gemm_phase(LAS unsigned char* lds, const half_t* A, const half_t* Bt, const int K, const int lda, const int ldb, const Sched& S, const Epi& E) {
  const int tid = threadIdx.x, wid = __builtin_amdgcn_readfirstlane(tid >> 6), lane = tid & 63, wr = wid >> 2, wc = wid & 3, fr = lane & 15, fq = lane >> 4;
  const int nt = K / BK;
  unsigned voffA[2], voffB[2];
#pragma unroll
  for (int i = 0; i < 2; ++i) { int R, C; stage_rc(tid * 16 + i * 8192, R, C); const int Rb = Epi::PERM ? ((R & ~31) + perm32(R & 31)) : R;
    voffA[i] = (unsigned)(R * lda + C) * 2u; voffB[i] = (unsigned)(Rb * ldb + C) * 2u; }
  const size_t kstep = (size_t)(BK * 2);
  const size_t hstepA = (size_t)HALF * lda * 2, hstepB = (size_t)HALF * ldb * 2;
  const unsigned ldsw = (unsigned)wid * 1024u;
  const int aoff = lds_byte(wr * 64 + fr, fq * 8), boff = lds_byte(wc * 32 + fr, fq * 8);
#define G8_SA(b, h) (((b) * 2 + (h)) * HTB)
#define G8_SB(b, h) ((4 + (b) * 2 + (h)) * HTB)
#define G8_STAGE(bufoff, gbase, voff) do { _Pragma("unroll") for (int _i = 0; _i < 2; ++_i) \
    __builtin_amdgcn_global_load_lds((const unsigned*)((const char*)(gbase) + (voff)[_i]), (LAS unsigned*)(lds + (bufoff) + ldsw + _i * 8192), 16, 0, 0); } while (0)
#define G8_LDA(dst, b, h) do { _Pragma("unroll") for (int m = 0; m < 4; ++m) _Pragma("unroll") for (int k = 0; k < 2; ++k) dst[m][k] = *(const LAS half8*)(lds + G8_SA(b, h) + aoff + m * 2048 + k * 1024); } while (0)
#define G8_LDB(dst, b, h) do { _Pragma("unroll") for (int n = 0; n < 2; ++n) _Pragma("unroll") for (int k = 0; k < 2; ++k) dst[n][k] = *(const LAS half8*)(lds + G8_SB(b, h) + boff + n * 2048 + k * 1024); } while (0)
#define G8_MMA(ai, bj, At, Bt_) do { __builtin_amdgcn_s_setprio(1); _Pragma("unroll") for (int m = 0; m < 4; ++m) _Pragma("unroll") for (int n = 0; n < 2; ++n) _Pragma("unroll") for (int k = 0; k < 2; ++k) \
    acc[ai][bj][m][n] = __builtin_amdgcn_mfma_f32_16x16x32_f16(Bt_[n][k], At[m][k], acc[ai][bj][m][n], 0, 0, 0); __builtin_amdgcn_s_setprio(0); } while (0)
#define G8_WAIT_V(n) asm volatile("s_waitcnt vmcnt(" #n ")" ::: "memory")
#define G8_WAIT_L(n) asm volatile("s_waitcnt lgkmcnt(" #n ")" ::: "memory")
#define G8_BAR __builtin_amdgcn_s_barrier()
#define G8_SCHED __builtin_amdgcn_sched_barrier(0)
  Unit cur, nxt; int ui = 0;
  if (!S.next(0, cur)) return;
  f32x4 acc[2][2][4][2];
#pragma unroll
  for (int a = 0; a < 2; ++a)
#pragma unroll
    for (int b = 0; b < 2; ++b)
#pragma unroll
      for (int m = 0; m < 4; ++m)
#pragma unroll
        for (int n = 0; n < 2; ++n) acc[a][b][m][n] = (f32x4){0.f, 0.f, 0.f, 0.f};
  half8 At[4][2], B0[2][2], B1[2][2];
  const char* cA = (const char*)A + cur.aoff; const char* cB = (const char*)Bt + cur.boff;
  G8_STAGE(G8_SB(0, 0), cB, voffB); G8_STAGE(G8_SA(0, 0), cA, voffA); G8_STAGE(G8_SB(0, 1), cB + hstepB, voffB); G8_STAGE(G8_SA(0, 1), cA + hstepA, voffA);
  if (wr == 1) G8_BAR;
  G8_WAIT_V(4); G8_BAR;
  G8_STAGE(G8_SB(1, 0), cB + kstep, voffB); G8_STAGE(G8_SA(1, 0), cA + kstep, voffA); G8_STAGE(G8_SB(1, 1), cB + hstepB + kstep, voffB);
  G8_WAIT_V(6); G8_BAR;
  for (;;) {
    const bool has_next = S.next(ui + 1, nxt);
    const char* nA = has_next ? (const char*)A + nxt.aoff : cA; const char* nB = has_next ? (const char*)Bt + nxt.boff : cB;
    for (int t = 0; t < nt; t += 2) {
      const bool last = (t == nt - 2);
      const char* a1 = cA + (size_t)(t + 1) * kstep;
      const char* a2 = last ? nA : cA + (size_t)(t + 2) * kstep; const char* b2 = last ? nB : cB + (size_t)(t + 2) * kstep;
      const char* a3 = a2 + kstep; const char* b3 = b2 + kstep;
      G8_LDB(B0, 0, 0); G8_SCHED; G8_LDA(At, 0, 0); G8_STAGE(G8_SA(1, 1), a1 + hstepA, voffA);
      G8_WAIT_L(8); G8_BAR; G8_WAIT_L(0); G8_MMA(0, 0, At, B0); G8_BAR; G8_SCHED;
      G8_LDB(B1, 0, 1); G8_STAGE(G8_SB(0, 0), b2, voffB);
      G8_BAR; G8_WAIT_L(0); G8_MMA(0, 1, At, B1); G8_BAR;
      G8_LDA(At, 0, 1); G8_STAGE(G8_SA(0, 0), a2, voffA);
      G8_BAR; G8_WAIT_L(0); G8_MMA(1, 0, At, B0); G8_BAR; G8_SCHED;
      G8_STAGE(G8_SB(0, 1), b2 + hstepB, voffB);
      G8_WAIT_V(6); G8_BAR; G8_MMA(1, 1, At, B1); G8_BAR;
      G8_LDB(B0, 1, 0); G8_SCHED; G8_LDA(At, 1, 0); G8_STAGE(G8_SA(0, 1), a2 + hstepA, voffA);
      G8_WAIT_L(8); G8_BAR; G8_WAIT_L(0); G8_MMA(0, 0, At, B0); G8_BAR; G8_SCHED;
      G8_LDB(B1, 1, 1); G8_STAGE(G8_SB(1, 0), b3, voffB);
      G8_BAR; G8_WAIT_L(0); G8_MMA(0, 1, At, B1); G8_BAR;
      G8_LDA(At, 1, 1); G8_STAGE(G8_SA(1, 0), a3, voffA);
      G8_BAR; G8_WAIT_L(0); G8_MMA(1, 0, At, B0); G8_BAR; G8_SCHED;
      G8_STAGE(G8_SB(1, 1), b3 + hstepB, voffB);
      G8_WAIT_V(6); G8_BAR; G8_MMA(1, 1, At, B1); G8_BAR;
    }
    E(acc, cur, wr, wc, fr, fq);
    if (!has_next) break;
#pragma unroll
    for (int a = 0; a < 2; ++a)
#pragma unroll
      for (int b = 0; b < 2; ++b)
#pragma unroll
        for (int m = 0; m < 4; ++m)
#pragma unroll
          for (int n = 0; n < 2; ++n) acc[a][b][m][n] = (f32x4){0.f, 0.f, 0.f, 0.f};
    cur = nxt; cA = nA; cB = nB; ++ui;
  }
  G8_WAIT_V(0);
  if (wr == 0) G8_BAR;
  G8_BAR;
#undef G8_SA
#undef G8_SB
#undef G8_STAGE
#undef G8_LDA
#undef G8_LDB
#undef G8_MMA
#undef G8_WAIT_V
#undef G8_WAIT_L
#undef G8_BAR
#undef G8_SCHED
}
__device__ __forceinline__ half8 pack8(f32x4 a, f32x4 b) { half8 o; o[0] = (half_t)a[0]; o[1] = (half_t)a[1]; o[2] = (half_t)a[2]; o[3] = (half_t)a[3]; o[4] = (half_t)b[0]; o[5] = (half_t)b[1]; o[6] = (half_t)b[2]; o[7] = (half_t)b[3]; return o; }
struct EpiHalf {
  static constexpr bool PERM = true;
  half_t* O; int ldc;
  __device__ __forceinline__ void operator()(const f32x4 (&acc)[2][2][4][2], const Unit& u, int wr, int wc, int fr, int fq) const {
    const int row0 = u.pm * BM + wr * 64 + fr, col0 = u.pn * BM + wc * 32 + 8 * fq;
#pragma unroll
    for (int ai = 0; ai < 2; ++ai)
#pragma unroll
      for (int m = 0; m < 4; ++m) { half_t* rowp = O + (size_t)(row0 + ai * HALF + m * 16) * ldc + col0;
#pragma unroll
        for (int bj = 0; bj < 2; ++bj) *(half8*)(rowp + bj * HALF) = pack8(acc[ai][bj][m][0], acc[ai][bj][m][1]); }
  }
};
struct EpiQlat {
  static constexpr bool PERM = true;
  half_t* O;
  __device__ __forceinline__ void operator()(const f32x4 (&acc)[2][2][4][2], const Unit& u, int wr, int wc, int fr, int fq) const {
    const int row0 = u.pm * BM + wr * 64 + fr, col0 = u.pn * BM + wc * 32 + 8 * fq;
#pragma unroll
    for (int ai = 0; ai < 2; ++ai)
#pragma unroll
      for (int m = 0; m < 4; ++m) { half_t* rowp = O + (size_t)(row0 + ai * HALF + m * 16) * 4096 + col0;
#pragma unroll
        for (int bj = 0; bj < 2; ++bj) *(half8*)(rowp + bj * HALF) = pack8(acc[ai][bj][m][0] * QSCALE, acc[ai][bj][m][1] * QSCALE); }
  }
};
struct EpiResid {
  static constexpr bool PERM = true;
  const float* x; const float* modf; half_t* x1;
  __device__ __forceinline__ void operator()(const f32x4 (&acc)[2][2][4][2], const Unit& u, int wr, int wc, int fr, int fq) const {
    const int row0 = u.pm * BM + wr * 64 + fr, col0 = u.pn * BM + wc * 32 + 8 * fq, b = (u.pm * BM) >> 11;
    f32x4 g[2][2];
#pragma unroll
    for (int bj = 0; bj < 2; ++bj) { const int c = col0 + bj * HALF; g[bj][0] = *(const f32x4*)(modf + b * MODN + 4096 + c); g[bj][1] = *(const f32x4*)(modf + b * MODN + 4096 + c + 4); }
#pragma unroll
    for (int ai = 0; ai < 2; ++ai) {
      f32x4 xv[4][2][2];
#pragma unroll
      for (int m = 0; m < 4; ++m)
#pragma unroll
        for (int bj = 0; bj < 2; ++bj) { const float* xp = x + (size_t)(row0 + ai * HALF + m * 16) * D + col0 + bj * HALF; xv[m][bj][0] = *(const f32x4*)xp; xv[m][bj][1] = *(const f32x4*)(xp + 4); }
#pragma unroll
      for (int m = 0; m < 4; ++m)
#pragma unroll
        for (int bj = 0; bj < 2; ++bj)
          *(half8*)(x1 + (size_t)(row0 + ai * HALF + m * 16) * D + col0 + bj * HALF) = pack8(xv[m][bj][0] + g[bj][0] * acc[ai][bj][m][0], xv[m][bj][1] + g[bj][1] * acc[ai][bj][m][1]);
    }
  }
};
struct EpiMoe1 {
  static constexpr bool PERM = true;
  half_t* act; const float* cslot;
  __device__ __forceinline__ void operator()(const f32x4 (&acc)[2][2][4][2], const Unit& u, int wr, int wc, int fr, int fq) const {
    const int row0 = u.pm * BM + wr * 64 + fr, col0 = u.pn * BM + wc * 32 + 8 * fq;
#pragma unroll
    for (int ai = 0; ai < 2; ++ai)
#pragma unroll
      for (int m = 0; m < 4; ++m) { const int slot = row0 + ai * HALF + m * 16; const float cw = cslot[slot];
#pragma unroll
        for (int bj = 0; bj < 2; ++bj) { const f32x4 v0 = acc[ai][bj][m][0], v1 = acc[ai][bj][m][1]; half4 o;
          o[0] = (half_t)(v0[0] / (1.0f + __expf(-v0[0])) * v0[1] * cw); o[1] = (half_t)(v0[2] / (1.0f + __expf(-v0[2])) * v0[3] * cw);
          o[2] = (half_t)(v1[0] / (1.0f + __expf(-v1[0])) * v1[1] * cw); o[3] = (half_t)(v1[2] / (1.0f + __expf(-v1[2])) * v1[3] * cw);
          *(half4*)(act + (size_t)slot * 512 + ((col0 + bj * HALF) >> 1)) = o; } }
  }
};
struct EpiMoe2 {
  static constexpr bool PERM = true;
  half_t* out2; const int* rowmap;
  __device__ __forceinline__ void operator()(const f32x4 (&acc)[2][2][4][2], const Unit& u, int wr, int wc, int fr, int fq) const {
    const int row0 = u.pm * BM + wr * 64 + fr, col0 = u.pn * BM + wc * 32 + 8 * fq;
#pragma unroll
    for (int ai = 0; ai < 2; ++ai)
#pragma unroll
      for (int m = 0; m < 4; ++m) { const int rm = rowmap[row0 + ai * HALF + m * 16];
        if (rm >= 0) { half_t* rowp = out2 + (size_t)rm * D + col0;
#pragma unroll
          for (int bj = 0; bj < 2; ++bj) *(half8*)(rowp + bj * HALF) = pack8(acc[ai][bj][m][0], acc[ai][bj][m][1]); } }
  }
};
}

__device__ void phase2(const Params& p, char* lds) {
  g8::DenseOrder S; S.init(NTOK, NPAD, D, gridDim.x, blockIdx.x);
  g8::EpiHalf E{(half_t*)(p.ws + WS_PROJ16), NPAD};
  g8::gemm_phase(( LAS unsigned char*)lds, (const half_t*)(p.ws + WS_H16), (const half_t*)(p.ws + WS_WIN16), D, D, D, S, E);
  if (defer_mode() && blockIdx.x >= 96) {
    const int w = blockIdx.x - 96;
    for (int d = w; d < 384; d += 160) p0_modpart_half(p, lds, d / 24, 8 + d % 24);
    if (w >= 64) for (int it = CV_WIN + (w - 64); it < CV_WR; it += 96) p0_convert(p, it);
  }
}

__device__ void index_block(const Params& p, char* lds, int b, int tb) {
  const int tid = threadIdx.x, lane = tid & 63, wid = tid >> 6;
  const half_t* proj = (const half_t*)(p.ws + WS_PROJ16);
  float* score = (float*)(p.ws + WS_SCORE);
  half_t* Bs = (half_t*)lds;
  const int t0 = b * SEQ + tb * 16;
  const int r = lane & 31, tokb = (r >> 2) & 1, head = (r & 3) + 4 * (r >> 3), kb = lane >> 5;
  half8 af[8];
  { const half_t* src = proj + (size_t)(t0 + 2 * wid + tokb) * NPAD + OFF_IQ + head * 128 + kb * 8;
#pragma unroll
    for (int ks = 0; ks < 8; ++ks) af[ks] = *(const half8*)(src + ks * 16); }
  float wgt[16];
  { const half_t* ws = proj + (size_t)(t0 + 2 * wid + kb) * NPAD + OFF_IW; const half8 w0 = *(const half8*)ws, w1 = *(const half8*)(ws + 8);
#pragma unroll
    for (int e = 0; e < 8; ++e) { wgt[e] = (float)w0[e] * IWSCALE; wgt[8 + e] = (float)w1[e] * IWSCALE; } }
  const int nkt = (tb * 16 + 15) / 128 + 1;
  const int lrow = tid >> 4, lc = (tid & 15) * 8;
  const half_t* bsrc = proj + (size_t)(b * SEQ + lrow) * NPAD + OFF_IK + lc;
  u32x4 rb[4];
#pragma unroll
  for (int i = 0; i < 4; ++i) rb[i] = *(const u32x4*)(bsrc + (size_t)(32 * i) * NPAD);
  LDS_BARRIER();
#pragma unroll
  for (int i = 0; i < 4; ++i) *(u32x4*)(Bs + (lrow + 32 * i) * 136 + lc) = rb[i];
  LDS_BARRIER();
  for (int kt = 0; kt < nkt; ++kt) {
    if (kt + 1 < nkt) {
#pragma unroll
      for (int i = 0; i < 4; ++i) rb[i] = *(const u32x4*)(bsrc + (size_t)((kt + 1) * 128 + 32 * i) * NPAD);
    }
    const half_t* bt = Bs + (kt & 1) * (128 * 136);
    half8 bfa[8], bfb[8];
#pragma unroll
    for (int ks = 0; ks < 8; ++ks) bfa[ks] = *(const half8*)(bt + (lane & 31) * 136 + ks * 16 + kb * 8);
#pragma unroll
    for (int sub = 0; sub < 4; ++sub) {
      f32x16 acc;
#pragma unroll
      for (int i = 0; i < 16; ++i) acc[i] = 0.f;
      if (sub + 1 < 4) {
#pragma unroll
        for (int ks = 0; ks < 8; ++ks) { const half8 nb = *(const half8*)(bt + ((sub + 1) * 32 + (lane & 31)) * 136 + ks * 16 + kb * 8); if (sub & 1) bfa[ks] = nb; else bfb[ks] = nb; }
      }
      __builtin_amdgcn_sched_barrier(0);
#pragma unroll
      for (int ks = 0; ks < 8; ++ks) acc = __builtin_amdgcn_mfma_f32_32x32x16_f16(af[ks], (sub & 1) ? bfb[ks] : bfa[ks], acc, 0, 0, 0);
      __builtin_amdgcn_sched_barrier(0);
      float s = 0.f, sb = 0.f;
#pragma unroll
      for (int i = 0; i < 16; i += 2) {
        const float r0 = __int_as_float(max(__float_as_int(acc[i]), 0)), r1 = __int_as_float(max(__float_as_int(acc[i + 1]), 0));
        s = fmaf(r0, wgt[i], s); sb = fmaf(r1, wgt[i + 1], sb); }
      s += sb;
      score[(size_t)(t0 + 2 * wid + kb) * SEQ + kt * 128 + sub * 32 + (lane & 31)] = s;
    }
    if (kt + 1 < nkt) {
#pragma unroll
      for (int i = 0; i < 4; ++i) *(u32x4*)(Bs + ((kt + 1) & 1) * (128 * 136) + (lrow + 32 * i) * 136 + lc) = rb[i];
    }
    LDS_BARRIER();
  }
}
__device__ __forceinline__ unsigned sortable(float f) { const unsigned u = __float_as_uint(f); return (u & 0x80000000u) ? ~u : (u | 0x80000000u); }
template <int JN> __device__ __forceinline__ int wave_count_ge(const float (&s)[JN], float cand) {
  int cnt = 0;
#pragma unroll
  for (int j = 0; j < JN; ++j) cnt += (s[j] >= cand) ? 1 : 0;
  int tot = 0;
#pragma unroll
  for (int b = 0; b < 6; ++b) tot += __popcll(__ballot((cnt >> b) & 1)) << b;
  return tot;
}
template <int JN> __device__ __forceinline__ void topk_body(float (&s)[JN], unsigned* mask, int pos);
template <int JN> __device__ __forceinline__ void topk_search2(const float* sc, unsigned* mask, int pos) {
  const int lane = threadIdx.x & 63;
  float s0[JN], s1[JN];
#pragma unroll
  for (int j = 0; j < JN; ++j) s0[j] = sc[lane + 64 * j];
#pragma unroll
  for (int j = 0; j < JN; ++j) s1[j] = sc[SEQ + lane + 64 * j];
  topk_body<JN>(s0, mask, pos);
  topk_body<JN>(s1, mask + 64, pos + 1);
}
template <int JN> __device__ __forceinline__ void topk_body(float (&s)[JN], unsigned* mask, int pos) {
  const int lane = threadIdx.x & 63, n = pos + 1;
#pragma unroll
  for (int j = 0; j < JN; ++j) { const int idx = lane + 64 * j; s[j] = (idx <= pos) ? s[j] : -INFINITY; }
  float vmax = -INFINITY, vmin = INFINITY;
#pragma unroll
  for (int j = 0; j < JN; ++j) { vmax = fmaxf(vmax, s[j]); vmin = fminf(vmin, (s[j] == -INFINITY) ? INFINITY : s[j]); }
  vmax = wave_max(vmax); vmin = -wave_max(-vmin);
  float lo = vmin, hi = vmax, thr = 0.f; int cl = n, ch = wave_count_ge<JN>(s, hi); bool found = false;
  if (ch == 256) { found = true; thr = hi; }
  else if (ch < 256) {
    for (int it = 0; it < 80; ++it) {
      float cand = (it < 14) ? (hi - (hi - lo) * ((float)(256 - ch) / (float)(cl - ch))) : 0.5f * (lo + hi);
      if (!(cand > lo && cand < hi)) cand = 0.5f * (lo + hi);
      if (!(cand > lo && cand < hi)) break;
      const int c = wave_count_ge<JN>(s, cand);
      if (c == 256) { found = true; thr = cand; break; }
      if (c > 256) { lo = cand; cl = c; } else { hi = cand; ch = c; }
    }
  }
  unsigned mlo = 0u, mhi = 0u;
  if (found) {
#pragma unroll
    for (int j = 0; j < JN; ++j) { const unsigned long long ms = __ballot(s[j] >= thr);
      if (lane == j) { mlo = (unsigned)ms; mhi = (unsigned)(ms >> 32); } }
  } else {
    const float tv = lo; const int need = 256 - ch;
    int eqseen = 0;
    const unsigned long long ltmask = (1ull << lane) - 1ull;
#pragma unroll
    for (int j = 0; j < JN; ++j) {
      const bool gt = s[j] > tv, eq = s[j] == tv;
      const unsigned long long meq = __ballot(eq);
      const bool take = gt || (eq && (eqseen + __popcll(meq & ltmask)) < need);
      const unsigned long long ms = __ballot(take);
      if (lane == j) { mlo = (unsigned)ms; mhi = (unsigned)(ms >> 32); }
      eqseen += __popcll(meq);
    }
  }
  if (lane < 32) { mask[2 * lane] = mlo; mask[2 * lane + 1] = mhi; }
}
__device__ void topk_pair(const Params& p, int t, int pos) {
  const int lane = threadIdx.x & 63;
  unsigned* mask = (unsigned*)(p.ws + WS_MASK) + (size_t)t * 64;
  if (pos + 2 <= 256) {
#pragma unroll
    for (int hh = 0; hh < 2; ++hh) { const int n = pos + hh + 1, lo = 32 * lane;
      mask[64 * hh + lane] = (n >= lo + 32) ? 0xFFFFFFFFu : (n > lo ? ((1u << (n - lo)) - 1u) : 0u); }
    return;
  }
  const float* sc = (const float*)(p.ws + WS_SCORE) + (size_t)t * SEQ;
  if (pos < 512) topk_search2<8>(sc, mask, pos); else if (pos < 1024) topk_search2<16>(sc, mask, pos); else if (pos < 1536) topk_search2<24>(sc, mask, pos); else topk_search2<32>(sc, mask, pos);
}
__device__ void p3_rows(const Params& p, int tfirst, int tstep) {
  const int lane = threadIdx.x & 63;
  const half_t* proj = (const half_t*)(p.ws + WS_PROJ16);
  float kg[8], cw[3][16], go[16];
#pragma unroll
  for (int e = 0; e < 8; ++e) kg[e] = p.kv_norm_g[lane * 8 + e];
#pragma unroll
  for (int hb = 0; hb < 2; ++hb)
#pragma unroll
    for (int e = 0; e < 8; ++e) { const int c = lane * 8 + 512 * hb + e; cw[0][hb * 8 + e] = p.conv_w[c]; cw[1][hb * 8 + e] = p.conv_w[1024 + c]; cw[2][hb * 8 + e] = p.conv_w[2048 + c]; go[hb * 8 + e] = p.g_conv_out[c]; }
  for (int t = tfirst; t < NTOK; t += tstep) {
    const half_t* pr = proj + (size_t)t * NPAD;
    const int pos = t & (SEQ - 1);
    const half8 v = *(const half8*)(pr + OFF_KV + lane * 8);
    half8 bg[2], c0[2], x0[2], c1[2], x1[2], c2[2], x2[2];
#pragma unroll
    for (int hb = 0; hb < 2; ++hb) { const int c = lane * 8 + 512 * hb;
      bg[hb] = *(const half8*)(pr + OFF_B + c); c0[hb] = *(const half8*)(pr + OFF_C + c); x0[hb] = *(const half8*)(pr + OFF_X + c);
      const half_t* p1 = pos >= 1 ? pr - NPAD : pr; const half_t* p2 = pos >= 2 ? pr - 2 * NPAD : pr;
      c1[hb] = *(const half8*)(p1 + OFF_C + c); x1[hb] = *(const half8*)(p1 + OFF_X + c); c2[hb] = *(const half8*)(p2 + OFF_C + c); x2[hb] = *(const half8*)(p2 + OFF_X + c); }
    {
      float f[8], ss = 0.f;
#pragma unroll
      for (int e = 0; e < 8; ++e) { f[e] = (float)v[e]; ss += f[e] * f[e]; }
      ss = wave_sum(ss);
      const float rstd = rsqrtf(ss * (1.0f / 512.f) + EPS);
      half8 o;
#pragma unroll
      for (int e = 0; e < 8; ++e) o[e] = (half_t)(f[e] * rstd * kg[e]);
      *(half8*)((half_t*)(p.ws + WS_CKV16) + (size_t)t * 512 + lane * 8) = o;
    }
    {
      float y[16], ss = 0.f;
#pragma unroll
      for (int hb = 0; hb < 2; ++hb)
#pragma unroll
        for (int e = 0; e < 8; ++e) {
          const float u0 = (float)c0[hb][e] * (float)x0[hb][e];
          const float u1 = pos >= 1 ? (float)c1[hb][e] * (float)x1[hb][e] : 0.f;
          const float u2 = pos >= 2 ? (float)c2[hb][e] * (float)x2[hb][e] : 0.f;
          const float cv = cw[0][hb * 8 + e] * u2 + cw[1][hb * 8 + e] * u1 + cw[2][hb * 8 + e] * u0;
          const float yy = (float)bg[hb][e] * cv; y[hb * 8 + e] = yy; ss += yy * yy;
        }
      ss = wave_sum(ss);
      const float rstd = rsqrtf(ss * (1.0f / 1024.f) + EPS);
      half_t* mix = (half_t*)(p.ws + WS_MIX16) + (size_t)t * D;
#pragma unroll
      for (int hb = 0; hb < 2; ++hb) { const int c = lane * 8 + 512 * hb; half8 o;
#pragma unroll
        for (int e = 0; e < 8; ++e) o[e] = (half_t)(y[hb * 8 + e] * rstd * go[hb * 8 + e]);
        *(half8*)(mix + c) = o; }
    }
  }
}
struct QlatOrder {
  int G, c;
  __device__ bool next(int i, g8::Unit& u) const {
    const int L = i * G + c; if (L >= 512) return false;
    const int pm = L >> 4, pn = L & 15, h = pn >> 1;
    u.pm = pm; u.pn = pn; u.aoff = ((size_t)pm * 256 * NPAD + OFF_Q + h * 128) * 2; u.boff = (size_t)pn * 256 * 128 * 2; return true;
  }
};
__device__ void phase3(const Params& p, char* lds) {
  const int wid = threadIdx.x >> 6, sub = p.sub;
  if (sub == 0 || sub == 1)
  for (int it = blockIdx.x; it < 256; it += gridDim.x) {
    const int b = it >> 6, jp = it & 63;
    for (int half = 0; half < 2; ++half) {
      const int tb = half ? (127 - jp) : jp;
      index_block(p, lds, b, tb);
      __syncthreads();
      topk_pair(p, b * SEQ + tb * 16 + 2 * wid, tb * 16 + 2 * wid);
      __syncthreads();
    }
  }
  if (sub == 0 || sub == 2)
  {
    QlatOrder S{(int)gridDim.x, (int)blockIdx.x};
    g8::EpiQlat E{(half_t*)(p.ws + WS_QLAT16)};
    __syncthreads();
    g8::gemm_phase((LAS unsigned char*)lds, (const half_t*)(p.ws + WS_PROJ16), (const half_t*)(p.ws + WS_WUK16), 128, NPAD, 128, S, E);
  }
  const bool mdo = defer_mode() && sub == 0;
  float mpart[KSPLIT], mbias = 0.f; int midx = 0;
  if (mdo) {
    const int tq = threadIdx.x < 192 ? (int)threadIdx.x : 191, idx = blockIdx.x * 192 + tq, b = idx / 12288, c = 4096 + idx % 12288;
    const float* part = (const float*)(p.ws + WS_PART);
    mbias = (c < 12288) ? p.b_ada[c] : p.b_ada_f[c - 12288];
#pragma unroll
    for (int ks = 0; ks < KSPLIT; ++ks) mpart[ks] = part[(size_t)(ks * 4 + b) * MODN + c];
    midx = b * MODN + c;
  }
  if (sub == 0 || sub == 3)
  p3_rows(p, blockIdx.x * 8 + wid, gridDim.x * 8);
  if (mdo && threadIdx.x < 192) { float s = mbias;
#pragma unroll
    for (int ks = 0; ks < KSPLIT; ++ks) s += mpart[ks];
    ((float*)(p.ws + WS_MOD))[midx] = s; }
}

__device__ __forceinline__ float quad_max(float x) {
  auto r = __builtin_amdgcn_permlane16_swap(__float_as_uint(x), __float_as_uint(x), false, false); x = fmaxf(__uint_as_float(r[0]), __uint_as_float(r[1]));
  auto q = __builtin_amdgcn_permlane32_swap(__float_as_uint(x), __float_as_uint(x), false, false); return fmaxf(__uint_as_float(q[0]), __uint_as_float(q[1])); }
__device__ __forceinline__ float quad_sum(float x) {
  auto r = __builtin_amdgcn_permlane16_swap(__float_as_uint(x), __float_as_uint(x), false, false); x = __uint_as_float(r[0]) + __uint_as_float(r[1]);
  auto q = __builtin_amdgcn_permlane32_swap(__float_as_uint(x), __float_as_uint(x), false, false); return __uint_as_float(q[0]) + __uint_as_float(q[1]); }
__device__ __forceinline__ half8 pack8h(f32x4 a, f32x4 b) { half8 o; o[0] = (half_t)a[0]; o[1] = (half_t)a[1]; o[2] = (half_t)a[2]; o[3] = (half_t)a[3]; o[4] = (half_t)b[0]; o[5] = (half_t)b[1]; o[6] = (half_t)b[2]; o[7] = (half_t)b[3]; return o; }
template <int OFF> __device__ __forceinline__ half4 tr_read(unsigned addr) { half4 r; asm volatile("ds_read_b64_tr_b16 %0, %1 offset:%2" : "=&v"(r) : "v"(addr), "i"(OFF) : "memory"); return r; }
__device__ __forceinline__ void attn_dma_tile(LAS char* L, const half_t* kvb, int kt, int buf, int wid, int lane) {
  const unsigned v0 = (((wid & 1) * 16 + (lane >> 4)) * 1024u) + (wid >> 1) * 256u + 16u * ((lane & 15) ^ ((lane >> 4) << 1));
  const char* tb = (const char*)(kvb + (size_t)kt * 32 * 512);
#pragma unroll
  for (int i = 0; i < 4; ++i)
    __builtin_amdgcn_global_load_lds((const unsigned*)(tb + ((v0 + i * 4096u) ^ (128u * (i & 1)))), (LAS unsigned*)(L + buf * 32768 + (wid * 4 + i) * 1024), 16, 0, 0);
}
__device__ __forceinline__ float bfi_f32(unsigned mask, float a, unsigned bbits) { unsigned r; asm("v_bfi_b32 %0, %1, %2, %3" : "=v"(r) : "v"(mask), "v"(__float_as_uint(a)), "s"(bbits)); return __uint_as_float(r); }
__device__ __forceinline__ float max3_raw(float a, float b, float c) { float r; asm("v_max3_f32 %0, %1, %2, %3" : "=v"(r) : "v"(a), "v"(b), "v"(c)); return r; }
__device__ __forceinline__ float max_raw(float a, float b) { float r; asm("v_max_f32 %0, %1, %2" : "=v"(r) : "v"(a), "v"(b)); return r; }
__device__ __forceinline__ float quad_max_raw(float x) {
  auto r = __builtin_amdgcn_permlane16_swap(__float_as_uint(x), __float_as_uint(x), false, false); x = max_raw(__uint_as_float(r[0]), __uint_as_float(r[1]));
  auto q = __builtin_amdgcn_permlane32_swap(__float_as_uint(x), __float_as_uint(x), false, false); return max_raw(__uint_as_float(q[0]), __uint_as_float(q[1])); }
#ifndef ATT_NQ
#define ATT_NQ 14
#define ATT_GROUPS ATT_QK(0, 3) ATT_QK(3, 3) ATT_QK(6, 3) ATT_QK(9, 3) ATT_QK(12, 2) ATT_QK(14, 2)
#endif
template <int STAGE> __device__ __forceinline__ void attn_task(const Params& p, char* lds, int b, int tb, int tb_prev) {
  int tid = threadIdx.x; asm volatile("" : "+v"(tid));
  const int lane = tid & 63, wid = __builtin_amdgcn_readfirstlane(tid >> 6), fr = lane & 15, fq = lane >> 4;
  LAS char* L = (LAS char*)lds;
  LAS unsigned* maskl = (LAS unsigned*)(L + 65536);
  const int t0 = b * SEQ + tb * 16;
  const int nkt = ((tb * 16 + 15) >> 5) + 1;
  const half_t* kvb = (const half_t*)(p.ws + WS_CKV16) + (size_t)b * SEQ * 512;
  __syncthreads();
  attn_dma_tile(L, kvb, 0, 0, wid, lane);
  { const unsigned* mg = (const unsigned*)(p.ws + WS_MASK) + (size_t)t0 * 64; maskl[tid] = mg[tid]; maskl[tid + 512] = mg[tid + 512]; }
  constexpr int NQ = ATT_NQ;
  half8 qf[NQ];
  LAS char* Lq = L + 73728 + wid * 10240 + lane * 16;
  { const half_t* qs = (const half_t*)(p.ws + WS_QLAT16) + (size_t)(t0 + fr) * 4096 + wid * 512 + fq * 8;
#pragma unroll
    for (int s = 0; s < NQ; ++s) qf[s] = *(const half8*)(qs + 32 * s);
#pragma unroll
    for (int s = NQ; s < 16; ++s) *(LAS half8*)(Lq + (s - NQ) * 1024) = *(const half8*)(qs + 32 * s); }
  const unsigned R2 = 256u * fr + ((16u * fq) ^ ((fr & 7u) << 5));
  const unsigned q4 = (lane & 15) >> 2, pp = lane & 3, rowt = 4 * fq + q4;
  const unsigned Rt = (unsigned)(size_t)L + 256u * rowt + ((rowt & 7u) << 5) + 16u * (pp >> 1) + 8u * (pp & 1);
  f32x4 o[32];
#pragma unroll
  for (int n = 0; n < 32; ++n) o[n] = (f32x4){0.f, 0.f, 0.f, 0.f};
  float m = -1e30f, l = 0.f;
  asm volatile("s_waitcnt vmcnt(0)" ::: "memory");
  __syncthreads();
  for (int kt = 0; kt < nkt; ++kt) {
    if (kt + 1 < nkt) attn_dma_tile(L, kvb, kt + 1, (kt + 1) & 1, wid, lane);
    const unsigned bo = (kt & 1) * 32768u;
    const float meff = (m > -1e29f) ? m : 0.f;
    f32x4 s0 = (f32x4){-meff, -meff, -meff, -meff}, s1 = s0;
#define ATT_QK(S0, N) { half8 ka[N], kb[N], qv[N]; \
      _Pragma("unroll") for (int i = 0; i < N; ++i) { const int s = (S0) + i; const unsigned ra = ((R2 + bo) ^ (64u * (s & 3))) + (s >> 2) * 8192u; \
        ka[i] = *(const LAS half8*)(L + ra); kb[i] = *(const LAS half8*)(L + ra + 4096); \
        qv[i] = (s < NQ) ? qf[s < NQ ? s : 0] : *(const LAS half8*)(Lq + (s < NQ ? 0 : s - NQ) * 1024); } \
      __builtin_amdgcn_sched_barrier(0); \
      _Pragma("unroll") for (int i = 0; i < N; ++i) { s0 = __builtin_amdgcn_mfma_f32_16x16x32_f16(ka[i], qv[i], s0, 0, 0, 0); s1 = __builtin_amdgcn_mfma_f32_16x16x32_f16(kb[i], qv[i], s1, 0, 0, 0); } \
      __builtin_amdgcn_sched_barrier(0); }
    ATT_GROUPS
#undef ATT_QK
    const unsigned mw = maskl[fr * 64 + kt] >> (4 * fq);
    float sv[8];
#pragma unroll
    for (int r = 0; r < 4; ++r) { const unsigned t0 = (unsigned)__builtin_amdgcn_sbfe((int)mw, r, 1), t1 = (unsigned)__builtin_amdgcn_sbfe((int)mw, 16 + r, 1);
      sv[r] = bfi_f32(t0, s0[r], 0xFF800000u); sv[4 + r] = bfi_f32(t1, s1[r], 0xFF800000u); }
    float mt = max_raw(max3_raw(max3_raw(sv[0], sv[1], sv[2]), sv[3], sv[4]), max3_raw(sv[5], sv[6], sv[7]));
    mt = quad_max_raw(mt) + meff;
    if (__any(mt > m + 8.0f)) {
      const float mn = fmaxf(m, mt), sc = __builtin_amdgcn_exp2f(m - mn), d = mn - meff;
      l *= sc; m = mn;
#pragma unroll
      for (int n = 0; n < 32; ++n) o[n] *= sc;
#pragma unroll
      for (int r = 0; r < 8; ++r) sv[r] -= d;
    }
    half8 pf; float ps = 0.f;
#pragma unroll
    for (int r = 0; r < 8; ++r) { const float pv = __builtin_amdgcn_exp2f(sv[r]); ps += pv; pf[r] = (half_t)pv; }
    l += ps;
asm volatile("s_waitcnt lgkmcnt(0)" ::: "memory"); __builtin_amdgcn_sched_barrier(0);
    const half4 xa0 = tr_read<0>((Rt + bo) ^ 0u), ya0 = tr_read<4096>((Rt + bo) ^ 0u), xb0 = tr_read<0>((Rt + bo) ^ 32u), yb0 = tr_read<4096>((Rt + bo) ^ 32u);
    const half4 xa1 = tr_read<0>((Rt + bo) ^ 64u), ya1 = tr_read<4096>((Rt + bo) ^ 64u), xb1 = tr_read<0>((Rt + bo) ^ 96u), yb1 = tr_read<4096>((Rt + bo) ^ 96u);
    asm volatile("s_waitcnt lgkmcnt(4)" ::: "memory"); __builtin_amdgcn_sched_barrier(0);
    o[0] = __builtin_amdgcn_mfma_f32_16x16x32_f16((half8){xa0[0], xa0[1], xa0[2], xa0[3], ya0[0], ya0[1], ya0[2], ya0[3]}, pf, o[0], 0, 0, 0);
    o[1] = __builtin_amdgcn_mfma_f32_16x16x32_f16((half8){xb0[0], xb0[1], xb0[2], xb0[3], yb0[0], yb0[1], yb0[2], yb0[3]}, pf, o[1], 0, 0, 0);
    __builtin_amdgcn_sched_barrier(0);
    const half4 xa2 = tr_read<0>((Rt + bo) ^ 128u), ya2 = tr_read<4096>((Rt + bo) ^ 128u), xb2 = tr_read<0>((Rt + bo) ^ 160u), yb2 = tr_read<4096>((Rt + bo) ^ 160u);
    asm volatile("s_waitcnt lgkmcnt(4)" ::: "memory"); __builtin_amdgcn_sched_barrier(0);
    o[2] = __builtin_amdgcn_mfma_f32_16x16x32_f16((half8){xa1[0], xa1[1], xa1[2], xa1[3], ya1[0], ya1[1], ya1[2], ya1[3]}, pf, o[2], 0, 0, 0);
    o[3] = __builtin_amdgcn_mfma_f32_16x16x32_f16((half8){xb1[0], xb1[1], xb1[2], xb1[3], yb1[0], yb1[1], yb1[2], yb1[3]}, pf, o[3], 0, 0, 0);
    __builtin_amdgcn_sched_barrier(0);
    const half4 xa3 = tr_read<0>((Rt + bo) ^ 192u), ya3 = tr_read<4096>((Rt + bo) ^ 192u), xb3 = tr_read<0>((Rt + bo) ^ 224u), yb3 = tr_read<4096>((Rt + bo) ^ 224u);
    asm volatile("s_waitcnt lgkmcnt(4)" ::: "memory"); __builtin_amdgcn_sched_barrier(0);
    o[4] = __builtin_amdgcn_mfma_f32_16x16x32_f16((half8){xa2[0], xa2[1], xa2[2], xa2[3], ya2[0], ya2[1], ya2[2], ya2[3]}, pf, o[4], 0, 0, 0);
    o[5] = __builtin_amdgcn_mfma_f32_16x16x32_f16((half8){xb2[0], xb2[1], xb2[2], xb2[3], yb2[0], yb2[1], yb2[2], yb2[3]}, pf, o[5], 0, 0, 0);
    __builtin_amdgcn_sched_barrier(0);
    const half4 xa4 = tr_read<8192>((Rt + bo) ^ 0u), ya4 = tr_read<12288>((Rt + bo) ^ 0u), xb4 = tr_read<8192>((Rt + bo) ^ 32u), yb4 = tr_read<12288>((Rt + bo) ^ 32u);
    asm volatile("s_waitcnt lgkmcnt(4)" ::: "memory"); __builtin_amdgcn_sched_barrier(0);
    o[6] = __builtin_amdgcn_mfma_f32_16x16x32_f16((half8){xa3[0], xa3[1], xa3[2], xa3[3], ya3[0], ya3[1], ya3[2], ya3[3]}, pf, o[6], 0, 0, 0);
    o[7] = __builtin_amdgcn_mfma_f32_16x16x32_f16((half8){xb3[0], xb3[1], xb3[2], xb3[3], yb3[0], yb3[1], yb3[2], yb3[3]}, pf, o[7], 0, 0, 0);
    __builtin_amdgcn_sched_barrier(0);
    const half4 xa5 = tr_read<8192>((Rt + bo) ^ 64u), ya5 = tr_read<12288>((Rt + bo) ^ 64u), xb5 = tr_read<8192>((Rt + bo) ^ 96u), yb5 = tr_read<12288>((Rt + bo) ^ 96u);
    asm volatile("s_waitcnt lgkmcnt(4)" ::: "memory"); __builtin_amdgcn_sched_barrier(0);
    o[8] = __builtin_amdgcn_mfma_f32_16x16x32_f16((half8){xa4[0], xa4[1], xa4[2], xa4[3], ya4[0], ya4[1], ya4[2], ya4[3]}, pf, o[8], 0, 0, 0);
    o[9] = __builtin_amdgcn_mfma_f32_16x16x32_f16((half8){xb4[0], xb4[1], xb4[2], xb4[3], yb4[0], yb4[1], yb4[2], yb4[3]}, pf, o[9], 0, 0, 0);
    __builtin_amdgcn_sched_barrier(0);
    const half4 xa6 = tr_read<8192>((Rt + bo) ^ 128u), ya6 = tr_read<12288>((Rt + bo) ^ 128u), xb6 = tr_read<8192>((Rt + bo) ^ 160u), yb6 = tr_read<12288>((Rt + bo) ^ 160u);
    asm volatile("s_waitcnt lgkmcnt(4)" ::: "memory"); __builtin_amdgcn_sched_barrier(0);
    o[10] = __builtin_amdgcn_mfma_f32_16x16x32_f16((half8){xa5[0], xa5[1], xa5[2], xa5[3], ya5[0], ya5[1], ya5[2], ya5[3]}, pf, o[10], 0, 0, 0);
    o[11] = __builtin_amdgcn_mfma_f32_16x16x32_f16((half8){xb5[0], xb5[1], xb5[2], xb5[3], yb5[0], yb5[1], yb5[2], yb5[3]}, pf, o[11], 0, 0, 0);
    __builtin_amdgcn_sched_barrier(0);
    const half4 xa7 = tr_read<8192>((Rt + bo) ^ 192u), ya7 = tr_read<12288>((Rt + bo) ^ 192u), xb7 = tr_read<8192>((Rt + bo) ^ 224u), yb7 = tr_read<12288>((Rt + bo) ^ 224u);
    asm volatile("s_waitcnt lgkmcnt(4)" ::: "memory"); __builtin_amdgcn_sched_barrier(0);
    o[12] = __builtin_amdgcn_mfma_f32_16x16x32_f16((half8){xa6[0], xa6[1], xa6[2], xa6[3], ya6[0], ya6[1], ya6[2], ya6[3]}, pf, o[12], 0, 0, 0);
    o[13] = __builtin_amdgcn_mfma_f32_16x16x32_f16((half8){xb6[0], xb6[1], xb6[2], xb6[3], yb6[0], yb6[1], yb6[2], yb6[3]}, pf, o[13], 0, 0, 0);
    __builtin_amdgcn_sched_barrier(0);
    const half4 xa8 = tr_read<16384>((Rt + bo) ^ 0u), ya8 = tr_read<20480>((Rt + bo) ^ 0u), xb8 = tr_read<16384>((Rt + bo) ^ 32u), yb8 = tr_read<20480>((Rt + bo) ^ 32u);
    asm volatile("s_waitcnt lgkmcnt(4)" ::: "memory"); __builtin_amdgcn_sched_barrier(0);
    o[14] = __builtin_amdgcn_mfma_f32_16x16x32_f16((half8){xa7[0], xa7[1], xa7[2], xa7[3], ya7[0], ya7[1], ya7[2], ya7[3]}, pf, o[14], 0, 0, 0);
    o[15] = __builtin_amdgcn_mfma_f32_16x16x32_f16((half8){xb7[0], xb7[1], xb7[2], xb7[3], yb7[0], yb7[1], yb7[2], yb7[3]}, pf, o[15], 0, 0, 0);
    __builtin_amdgcn_sched_barrier(0);
    const half4 xa9 = tr_read<16384>((Rt + bo) ^ 64u), ya9 = tr_read<20480>((Rt + bo) ^ 64u), xb9 = tr_read<16384>((Rt + bo) ^ 96u), yb9 = tr_read<20480>((Rt + bo) ^ 96u);
    asm volatile("s_waitcnt lgkmcnt(4)" ::: "memory"); __builtin_amdgcn_sched_barrier(0);
    o[16] = __builtin_amdgcn_mfma_f32_16x16x32_f16((half8){xa8[0], xa8[1], xa8[2], xa8[3], ya8[0], ya8[1], ya8[2], ya8[3]}, pf, o[16], 0, 0, 0);
    o[17] = __builtin_amdgcn_mfma_f32_16x16x32_f16((half8){xb8[0], xb8[1], xb8[2], xb8[3], yb8[0], yb8[1], yb8[2], yb8[3]}, pf, o[17], 0, 0, 0);
    __builtin_amdgcn_sched_barrier(0);
    const half4 xa10 = tr_read<16384>((Rt + bo) ^ 128u), ya10 = tr_read<20480>((Rt + bo) ^ 128u), xb10 = tr_read<16384>((Rt + bo) ^ 160u), yb10 = tr_read<20480>((Rt + bo) ^ 160u);
    asm volatile("s_waitcnt lgkmcnt(4)" ::: "memory"); __builtin_amdgcn_sched_barrier(0);
    o[18] = __builtin_amdgcn_mfma_f32_16x16x32_f16((half8){xa9[0], xa9[1], xa9[2], xa9[3], ya9[0], ya9[1], ya9[2], ya9[3]}, pf, o[18], 0, 0, 0);
    o[19] = __builtin_amdgcn_mfma_f32_16x16x32_f16((half8){xb9[0], xb9[1], xb9[2], xb9[3], yb9[0], yb9[1], yb9[2], yb9[3]}, pf, o[19], 0, 0, 0);
    __builtin_amdgcn_sched_barrier(0);
    const half4 xa11 = tr_read<16384>((Rt + bo) ^ 192u), ya11 = tr_read<20480>((Rt + bo) ^ 192u), xb11 = tr_read<16384>((Rt + bo) ^ 224u), yb11 = tr_read<20480>((Rt + bo) ^ 224u);
    asm volatile("s_waitcnt lgkmcnt(4)" ::: "memory"); __builtin_amdgcn_sched_barrier(0);
    o[20] = __builtin_amdgcn_mfma_f32_16x16x32_f16((half8){xa10[0], xa10[1], xa10[2], xa10[3], ya10[0], ya10[1], ya10[2], ya10[3]}, pf, o[20], 0, 0, 0);
    o[21] = __builtin_amdgcn_mfma_f32_16x16x32_f16((half8){xb10[0], xb10[1], xb10[2], xb10[3], yb10[0], yb10[1], yb10[2], yb10[3]}, pf, o[21], 0, 0, 0);
    __builtin_amdgcn_sched_barrier(0);
    const half4 xa12 = tr_read<24576>((Rt + bo) ^ 0u), ya12 = tr_read<28672>((Rt + bo) ^ 0u), xb12 = tr_read<24576>((Rt + bo) ^ 32u), yb12 = tr_read<28672>((Rt + bo) ^ 32u);
    asm volatile("s_waitcnt lgkmcnt(4)" ::: "memory"); __builtin_amdgcn_sched_barrier(0);
    o[22] = __builtin_amdgcn_mfma_f32_16x16x32_f16((half8){xa11[0], xa11[1], xa11[2], xa11[3], ya11[0], ya11[1], ya11[2], ya11[3]}, pf, o[22], 0, 0, 0);
    o[23] = __builtin_amdgcn_mfma_f32_16x16x32_f16((half8){xb11[0], xb11[1], xb11[2], xb11[3], yb11[0], yb11[1], yb11[2], yb11[3]}, pf, o[23], 0, 0, 0);
    __builtin_amdgcn_sched_barrier(0);
    const half4 xa13 = tr_read<24576>((Rt + bo) ^ 64u), ya13 = tr_read<28672>((Rt + bo) ^ 64u), xb13 = tr_read<24576>((Rt + bo) ^ 96u), yb13 = tr_read<28672>((Rt + bo) ^ 96u);
    asm volatile("s_waitcnt lgkmcnt(4)" ::: "memory"); __builtin_amdgcn_sched_barrier(0);
    o[24] = __builtin_amdgcn_mfma_f32_16x16x32_f16((half8){xa12[0], xa12[1], xa12[2], xa12[3], ya12[0], ya12[1], ya12[2], ya12[3]}, pf, o[24], 0, 0, 0);
    o[25] = __builtin_amdgcn_mfma_f32_16x16x32_f16((half8){xb12[0], xb12[1], xb12[2], xb12[3], yb12[0], yb12[1], yb12[2], yb12[3]}, pf, o[25], 0, 0, 0);
    __builtin_amdgcn_sched_barrier(0);
    const half4 xa14 = tr_read<24576>((Rt + bo) ^ 128u), ya14 = tr_read<28672>((Rt + bo) ^ 128u), xb14 = tr_read<24576>((Rt + bo) ^ 160u), yb14 = tr_read<28672>((Rt + bo) ^ 160u);
    asm volatile("s_waitcnt lgkmcnt(4)" ::: "memory"); __builtin_amdgcn_sched_barrier(0);
    o[26] = __builtin_amdgcn_mfma_f32_16x16x32_f16((half8){xa13[0], xa13[1], xa13[2], xa13[3], ya13[0], ya13[1], ya13[2], ya13[3]}, pf, o[26], 0, 0, 0);
    o[27] = __builtin_amdgcn_mfma_f32_16x16x32_f16((half8){xb13[0], xb13[1], xb13[2], xb13[3], yb13[0], yb13[1], yb13[2], yb13[3]}, pf, o[27], 0, 0, 0);
    __builtin_amdgcn_sched_barrier(0);
    const half4 xa15 = tr_read<24576>((Rt + bo) ^ 192u), ya15 = tr_read<28672>((Rt + bo) ^ 192u), xb15 = tr_read<24576>((Rt + bo) ^ 224u), yb15 = tr_read<28672>((Rt + bo) ^ 224u);
    asm volatile("s_waitcnt lgkmcnt(4)" ::: "memory"); __builtin_amdgcn_sched_barrier(0);
    o[28] = __builtin_amdgcn_mfma_f32_16x16x32_f16((half8){xa14[0], xa14[1], xa14[2], xa14[3], ya14[0], ya14[1], ya14[2], ya14[3]}, pf, o[28], 0, 0, 0);
    o[29] = __builtin_amdgcn_mfma_f32_16x16x32_f16((half8){xb14[0], xb14[1], xb14[2], xb14[3], yb14[0], yb14[1], yb14[2], yb14[3]}, pf, o[29], 0, 0, 0);
    __builtin_amdgcn_sched_barrier(0);
    asm volatile("s_waitcnt lgkmcnt(0)" ::: "memory"); __builtin_amdgcn_sched_barrier(0);
    o[30] = __builtin_amdgcn_mfma_f32_16x16x32_f16((half8){xa15[0], xa15[1], xa15[2], xa15[3], ya15[0], ya15[1], ya15[2], ya15[3]}, pf, o[30], 0, 0, 0);
    o[31] = __builtin_amdgcn_mfma_f32_16x16x32_f16((half8){xb15[0], xb15[1], xb15[2], xb15[3], yb15[0], yb15[1], yb15[2], yb15[3]}, pf, o[31], 0, 0, 0);
    __builtin_amdgcn_sched_barrier(0);
    asm volatile("s_waitcnt vmcnt(0)" ::: "memory");
    __syncthreads();
  }
  l = quad_sum(l);
  const float inv = 1.0f / l;
  int lane_e = lane, fr_e = fr, fq_e = fq;
  asm volatile("" : "+v"(lane_e), "+v"(fr_e), "+v"(fq_e));
  half8* osave = (half8*)(p.ws + WS_OSAVE) + ((size_t)(blockIdx.x * 8 + wid) * 16) * 64 + lane_e;
  if (STAGE == 0) {
#pragma unroll
    for (int s = 0; s < 16; ++s) { const f32x4 oa = o[2 * s] * inv, ob = o[2 * s + 1] * inv; osave[s * 64] = pack8h(oa, ob); }
    return;
  }
  half8 of1[16];
#pragma unroll
  for (int s = 0; s < 16; ++s) of1[s] = pack8h(o[2 * s] * inv, o[2 * s + 1] * inv);
  f32x4 y0[8], y1[8];
#pragma unroll
  for (int dt = 0; dt < 8; ++dt) { y0[dt] = (f32x4){0.f, 0.f, 0.f, 0.f}; y1[dt] = (f32x4){0.f, 0.f, 0.f, 0.f}; }
  const half_t* wp = (const half_t*)(p.ws + WS_WUV16) + (size_t)(wid * 128 + fr_e) * 512 + fq_e * 8;
  half8 wa[8], wb[8], oa, ob;
#pragma unroll
  for (int dt = 0; dt < 8; ++dt) wa[dt] = *(const half8*)(wp + (size_t)dt * 16 * 512);
  oa = osave[0];
#pragma unroll
  for (int s = 0; s < 16; s += 2) {
#pragma unroll
    for (int dt = 0; dt < 8; ++dt) wb[dt] = *(const half8*)(wp + (size_t)dt * 16 * 512 + 32 * (s + 1));
    ob = osave[(s + 1) * 64];
    __builtin_amdgcn_sched_barrier(0);
#pragma unroll
    for (int dt = 0; dt < 8; ++dt) { y1[dt] = __builtin_amdgcn_mfma_f32_16x16x32_f16(wa[dt], of1[s], y1[dt], 0, 0, 0); y0[dt] = __builtin_amdgcn_mfma_f32_16x16x32_f16(wa[dt], oa, y0[dt], 0, 0, 0); }
    if (s + 2 < 16) {
#pragma unroll
      for (int dt = 0; dt < 8; ++dt) wa[dt] = *(const half8*)(wp + (size_t)dt * 16 * 512 + 32 * (s + 2));
      oa = osave[(s + 2) * 64];
    }
    __builtin_amdgcn_sched_barrier(0);
#pragma unroll
    for (int dt = 0; dt < 8; ++dt) { y1[dt] = __builtin_amdgcn_mfma_f32_16x16x32_f16(wb[dt], of1[s + 1], y1[dt], 0, 0, 0); y0[dt] = __builtin_amdgcn_mfma_f32_16x16x32_f16(wb[dt], ob, y0[dt], 0, 0, 0); }
  }
  float4 gv[8];
#pragma unroll
  for (int dt = 0; dt < 8; ++dt) gv[dt] = *(const float4*)(p.g_attn_out + wid * 128 + dt * 16 + 4 * fq_e);
  float ss0 = 0.f, ss1 = 0.f;
#pragma unroll
  for (int dt = 0; dt < 8; ++dt) { ss0 += y0[dt][0] * y0[dt][0] + y0[dt][1] * y0[dt][1] + y0[dt][2] * y0[dt][2] + y0[dt][3] * y0[dt][3];
    ss1 += y1[dt][0] * y1[dt][0] + y1[dt][1] * y1[dt][1] + y1[dt][2] * y1[dt][2] + y1[dt][3] * y1[dt][3]; }
  ss0 = quad_sum(ss0); ss1 = quad_sum(ss1);
  LAS float* red = (LAS float*)(L + 65536 + 4096);
  if (fq_e == 0) { red[fr_e * 8 + wid] = ss0; red[128 + fr_e * 8 + wid] = ss1; }
  __syncthreads();
  float tot0 = 0.f, tot1 = 0.f;
#pragma unroll
  for (int w = 0; w < 8; ++w) { tot0 += red[fr_e * 8 + w]; tot1 += red[128 + fr_e * 8 + w]; }
  const float rstd0 = rsqrtf(tot0 * (1.0f / 1024.f) + EPS), rstd1 = rsqrtf(tot1 * (1.0f / 1024.f) + EPS);
  half_t* mp0 = (half_t*)(p.ws + WS_MIX16) + (size_t)(b * SEQ + tb_prev * 16 + fr_e) * D + 1024 + wid * 128 + 4 * fq_e;
  half_t* mp1 = (half_t*)(p.ws + WS_MIX16) + (size_t)(t0 + fr_e) * D + 1024 + wid * 128 + 4 * fq_e;
#pragma unroll
  for (int dt = 0; dt < 8; ++dt) { const float4 g = gv[dt];
    half4 ov; ov[0] = (half_t)(y0[dt][0] * rstd0 * g.x); ov[1] = (half_t)(y0[dt][1] * rstd0 * g.y); ov[2] = (half_t)(y0[dt][2] * rstd0 * g.z); ov[3] = (half_t)(y0[dt][3] * rstd0 * g.w);
    *(half4*)(mp0 + dt * 16) = ov;
    ov[0] = (half_t)(y1[dt][0] * rstd1 * g.x); ov[1] = (half_t)(y1[dt][1] * rstd1 * g.y); ov[2] = (half_t)(y1[dt][2] * rstd1 * g.z); ov[3] = (half_t)(y1[dt][3] * rstd1 * g.w);
    *(half4*)(mp1 + dt * 16) = ov; }
}
__device__ void phase4(const Params& p, char* lds) {
  for (int it = blockIdx.x; it < 256; it += gridDim.x) {
    const int b = it >> 6, jp = it & 63;
    attn_task<0>(p, lds, b, jp, 0);
    attn_task<1>(p, lds, b, 127 - jp, jp);
  }
}

__device__ void phase6(const Params& p, char* lds) {
  g8::DenseOrder S; S.init(NTOK, D, D, gridDim.x, blockIdx.x);
  g8::EpiResid E{p.x, (const float*)(p.ws + WS_MOD), (half_t*)(p.ws + WS_X1H)};
  g8::gemm_phase((LAS unsigned char*)lds, (const half_t*)(p.ws + WS_MIX16), (const half_t*)(p.ws + WS_WOUT16), D, D, D, S, E);
}

__device__ void phase7(const Params& p, char* lds) {
  const int tid = threadIdx.x, lane = tid & 63, wid = tid >> 6, fr = lane & 15, fq = lane >> 4;
  half_t* tile = (half_t*)lds;
  float* logit = (float*)(lds + 32 * 2056 * 2);
  int* e1s = (int*)(logit + 32 * 48); int* e2s = e1s + 32; float* rbias = (float*)(e2s + 32);
  const float* modf = (const float*)(p.ws + WS_MOD); half_t* h2 = (half_t*)(p.ws + WS_H2_16); const half_t* wr = (const half_t*)(p.ws + WS_WR16);
  int* rowmap = (int*)(p.ws + WS_RM2); float* cslot = (float*)(p.ws + WS_CS2); unsigned* ecnt = (unsigned*)(p.ws + WS_BAR) + EXP_CNT;
  for (int rg = blockIdx.x; rg < 256; rg += gridDim.x) {
    const int t0 = rg * 32, b = t0 >> 11;
    if (tid < 36) rbias[tid] = tid < 4 ? p.b_rg[tid] : p.b_re[tid - 4];
    f32x4 s2[4][2], h2m[4][2];
#pragma unroll
    for (int j = 0; j < 4; ++j)
#pragma unroll
      for (int h = 0; h < 2; ++h) { const int c = lane * 8 + 512 * j + 4 * h;
        s2[j][h] = *(const f32x4*)(p.g_ffn + c) * (*(const f32x4*)(modf + b * MODN + 8192 + c) + 1.0f); h2m[j][h] = *(const f32x4*)(modf + b * MODN + 6144 + c); }
    half8 va[4][4];
#pragma unroll
    for (int i = 0; i < 4; ++i) { const half_t* xr = (const half_t*)(p.ws + WS_X1H) + (size_t)(t0 + wid * 4 + i) * D;
#pragma unroll
      for (int j = 0; j < 4; ++j) va[i][j] = *(const half8*)(xr + lane * 8 + 512 * j); }
#pragma unroll
    for (int i = 0; i < 4; ++i) {
      const int lr = wid * 4 + i, t = t0 + lr;
      float ss = 0.f;
#pragma unroll
      for (int j = 0; j < 4; ++j) {
#pragma unroll
        for (int e = 0; e < 8; ++e) ss += (float)va[i][j][e] * (float)va[i][j][e]; }
      ss = wave_sum(ss);
      const float rstd = rsqrtf(ss * (1.0f / D) + EPS);
#pragma unroll
      for (int j = 0; j < 4; ++j) { const int c = lane * 8 + 512 * j;
        half8 o;
#pragma unroll
        for (int e = 0; e < 8; ++e) o[e] = (half_t)((float)va[i][j][e] * rstd * s2[j][e >> 2][e & 3] + h2m[j][e >> 2][e & 3]);
        *(half8*)(tile + lr * 2056 + c) = o; *(half8*)(h2 + (size_t)t * D + c) = o; }
    }
    __syncthreads();
    if (wid < 6) {
      const int m = wid / 3, n = wid % 3; f32x4 acc = (f32x4){0.f, 0.f, 0.f, 0.f};
      const half_t* ap = tile + (m * 16 + fr) * 2056 + fq * 8; const half_t* bp = wr + (size_t)(n * 16 + fr) * D + fq * 8;
      half8 bw0[8], bw1[8];
#pragma unroll
      for (int i = 0; i < 8; ++i) bw0[i] = *(const half8*)(bp + i * 32);
#pragma unroll
      for (int sb = 0; sb < 8; sb += 2) {
#pragma unroll
        for (int i = 0; i < 8; ++i) bw1[i] = *(const half8*)(bp + ((sb + 1) * 8 + i) * 32);
        __builtin_amdgcn_sched_barrier(0);
        half8 ta[8];
#pragma unroll
        for (int i = 0; i < 8; ++i) ta[i] = *(const half8*)(ap + (sb * 8 + i) * 32);
        __builtin_amdgcn_sched_barrier(0);
#pragma unroll
        for (int i = 0; i < 8; ++i) acc = __builtin_amdgcn_mfma_f32_16x16x32_f16(ta[i], bw0[i], acc, 0, 0, 0);
        if (sb + 2 < 8) {
#pragma unroll
          for (int i = 0; i < 8; ++i) bw0[i] = *(const half8*)(bp + ((sb + 2) * 8 + i) * 32);
        }
        __builtin_amdgcn_sched_barrier(0);
        half8 tb8[8];
#pragma unroll
        for (int i = 0; i < 8; ++i) tb8[i] = *(const half8*)(ap + ((sb + 1) * 8 + i) * 32);
        __builtin_amdgcn_sched_barrier(0);
#pragma unroll
        for (int i = 0; i < 8; ++i) acc = __builtin_amdgcn_mfma_f32_16x16x32_f16(tb8[i], bw1[i], acc, 0, 0, 0);
      }
#pragma unroll
      for (int r = 0; r < 4; ++r) logit[(m * 16 + fq * 4 + r) * 48 + n * 16 + fr] = acc[r];
    }
    __syncthreads();
    int e1g = 0, e2g = 0; float c1 = 0.f, c2 = 0.f;
    if (tid < 32) {
      const float* l = logit + tid * 48;
      float gl[4]; int g = 0; float gm = -INFINITY;
#pragma unroll
      for (int i = 0; i < 4; ++i) { gl[i] = l[i] + rbias[i]; if (gl[i] > gm) { gm = gl[i]; g = i; } }
      float gs = 0.f;
#pragma unroll
      for (int i = 0; i < 4; ++i) gs += __expf(gl[i] - gm);
      const float pg = 1.0f / gs;
      float el[8]; int i1 = 0; float m1 = -INFINITY;
#pragma unroll
      for (int i = 0; i < 8; ++i) { el[i] = l[4 + g * 8 + i] + rbias[4 + g * 8 + i]; if (el[i] > m1) { m1 = el[i]; i1 = i; } }
      int i2 = 0; float m2 = -INFINITY;
#pragma unroll
      for (int i = 0; i < 8; ++i) if (i != i1 && el[i] > m2) { m2 = el[i]; i2 = i; }
      const float w1 = 1.0f / (1.0f + __expf(m2 - m1)), w2 = 1.0f - w1;
      e1g = g * 8 + i1; e2g = g * 8 + i2; c1 = pg * w1; c2 = pg * w2;
      e1s[tid] = e1g; e2s[tid] = e2g;
    }
    __syncthreads();
    if (tid < 32) {
      int r1 = 0, r2 = 0, cnt = 0;
#pragma unroll
      for (int r = 0; r < 32; ++r) { const int a = e1s[r], bb = e2s[r];
        if (r < tid) { r1 += (a == e1g || bb == e1g); r2 += (a == e2g || bb == e2g); }
        cnt += (a == tid || bb == tid); }
      int off = 0;
      if (cnt) off = (int)__hip_atomic_fetch_add(ecnt + 64 * tid, (unsigned)cnt, __ATOMIC_RELAXED, __HIP_MEMORY_SCOPE_AGENT);
      const int o1 = __shfl(off, e1g), o2 = __shfl(off, e2g);
      const int t = t0 + tid, s1 = e1g * 8192 + o1 + r1, s2 = e2g * 8192 + o2 + r2;
      rowmap[s1] = 2 * t; rowmap[s2] = 2 * t + 1; cslot[s1] = c1; cslot[s2] = c2;
    }
    __syncthreads();
  }
}

__device__ __forceinline__ u32x4 pair16(half4 a, half4 b) {
  typedef unsigned u32x2 __attribute__((ext_vector_type(2)));
  const u32x2 ua = __builtin_bit_cast(u32x2, a), ub = __builtin_bit_cast(u32x2, b);
  auto r0 = __builtin_amdgcn_permlane32_swap(ua[0], ub[0], false, false); auto r1 = __builtin_amdgcn_permlane32_swap(ua[1], ub[1], false, false);
  return (u32x4){r0[0], r1[0], r0[1], r1[1]};
}
template <int MODE, int NM>
__device__ __forceinline__ void moe_consume(const Params& p, LAS char* L, int wid, int lane, int slot0, int rs0, int nrows, int pass0, int e, int nc) {
  constexpr int K = MODE ? 512 : D, NST = K / 64, LDB = MODE ? D : 512;
  const int wr2 = wid >> 1, wc2 = wid & 1, l31 = lane & 31, lh = lane >> 5;
  const int* rowmap = (const int*)(p.ws + WS_RM2);
  const unsigned n0 = 64 * wc2 + (l31 & ~3);
  const unsigned pb0 = (n0 | ((l31 + (l31 >> 4)) & 3)) * 16u + lh * 2048u, pb1 = ((n0 + 32) | ((l31 + 2 + (l31 >> 4)) & 3)) * 16u + lh * 2048u;
  const unsigned pa0 = (unsigned)(wr2 * 32 + l31) * 128u + 16u * (lh ^ ((l31 >> 1) & 7)), pa1 = pa0 ^ 32u, pa2 = pa0 ^ 64u, pa3 = pa0 ^ 96u;
  const char* pfb = MODE ? (const char*)(p.w_down + (size_t)e * 512 * D + 128 * nc) : (const char*)(((wid >> 1) ? p.w_up : p.w_gate) + (size_t)e * D * 512 + 64 * nc);
  const unsigned pfo = MODE ? (unsigned)(((wid * 64 + lane) >> 2) * (D * 4) + ((wid * 64 + lane) & 3) * 128) : (unsigned)(((((wid & 1) * 64 + lane) >> 1)) * (512 * 4) + (lane & 1) * 128);
  const __amdgpu_buffer_rsrc_t prs = __builtin_amdgcn_make_buffer_rsrc((void*)pfb, (short)0, (int)(K * LDB * 4), 0x00020000);
#define MOE_PF(S) __builtin_amdgcn_raw_ptr_buffer_load_lds(prs, (LAS void*)(L + 155648 + wid * 256), 4, pfo, (S) * (64 * LDB * 4), 0, 0)
  f32x16 acc[5][2];
#pragma unroll
  for (int m = 0; m < 5; ++m)
#pragma unroll
    for (int j = 0; j < 2; ++j)
#pragma unroll
      for (int i = 0; i < 16; ++i) acc[m][j][i] = 0.f;
  half8 a0[NM], a1[NM], b00, b01, b10, b11;
#define MOE_RD(AV, B0, B1, PA, T) do { B0 = *(const LAS half8*)(rB + pb0 + (T) * 4096); B1 = *(const LAS half8*)(rB + pb1 + (T) * 4096); \
    _Pragma("unroll") for (int m = 0; m < NM; ++m) AV[m] = *(const LAS half8*)(rA + (PA) + m * 8192); __builtin_amdgcn_sched_barrier(0); } while (0)
#define MOE_MM(AV, B0, B1) do { _Pragma("unroll") for (int m = 0; m < NM; ++m) { acc[m][0] = __builtin_amdgcn_mfma_f32_32x32x16_f16(B0, AV[m], acc[m][0], 0, 0, 0); \
      acc[m][1] = __builtin_amdgcn_mfma_f32_32x32x16_f16(B1, AV[m], acc[m][1], 0, 0, 0); } __builtin_amdgcn_sched_barrier(0); } while (0)
  LDS_BARRIER();
  const LAS char* rB = L; const LAS char* rA = L + 32768;
  MOE_RD(a0, b00, b01, pa0, 0);
#pragma unroll 1
  for (int s = 0; s < NST; ++s) {
    MOE_RD(a1, b10, b11, pa1, 1); MOE_MM(a0, b00, b01);
    MOE_RD(a0, b00, b01, pa2, 2); MOE_MM(a1, b10, b11);
    MOE_RD(a1, b10, b11, pa3, 3); MOE_MM(a0, b00, b01);
    LDS_BARRIER();
    rB = L + ((s + 1) & 1) * 16384; rA = (rA == L + 32768 + 2 * 40960) ? L + 32768 : rA + 40960;
    if (s + 1 < NST) MOE_RD(a0, b00, b01, pa0, 0);
    MOE_MM(a1, b10, b11);
  }
#undef MOE_RD
#undef MOE_MM
#undef MOE_PF
  float cwv[NM]; int rmv[NM];
#pragma unroll
  for (int m = 0; m < NM; ++m) { int lr = pass0 + (2 * m + wr2) * 32 + l31; if (lr >= nrows) lr = nrows - 1;
    if (MODE == 0) cwv[m] = ((const float*)(p.ws + WS_CS2))[rs0 + lr]; else rmv[m] = rowmap[rs0 + lr]; }
#pragma unroll
  for (int m = 0; m < NM; ++m) { const int lr = pass0 + (2 * m + wr2) * 32 + l31; if (lr < nrows) {
    const int slot = slot0 + lr;
    if (MODE == 0) {
      const float cw = cwv[m];
      half_t* ap = (half_t*)(p.ws + WS_ACT16) + (size_t)slot * 512 + 64 * nc + 32 * wc2 + 8 * lh;
#pragma unroll
      for (int pr = 0; pr < 2; ++pr) { half4 oa, ob;
#pragma unroll
        for (int i = 0; i < 4; ++i) { const float g = acc[m][0][pr * 8 + i], u = acc[m][1][pr * 8 + i]; oa[i] = (half_t)(g / (1.0f + __expf(-g)) * u * cw);
          const float g2 = acc[m][0][pr * 8 + 4 + i], u2 = acc[m][1][pr * 8 + 4 + i]; ob[i] = (half_t)(g2 / (1.0f + __expf(-g2)) * u2 * cw); }
        *(u32x4*)(ap + 16 * pr) = pair16(oa, ob); }
    } else {
      half_t* op = (half_t*)(p.ws + WS_OUT2) + (size_t)rmv[m] * D + 128 * nc + 64 * wc2 + 8 * lh;
#pragma unroll
      for (int nb = 0; nb < 2; ++nb)
#pragma unroll
        for (int pr = 0; pr < 2; ++pr) { half4 oa, ob;
#pragma unroll
          for (int i = 0; i < 4; ++i) { oa[i] = (half_t)acc[m][nb][pr * 8 + i]; ob[i] = (half_t)acc[m][nb][pr * 8 + 4 + i]; }
          *(u32x4*)(op + 32 * nb + 16 * pr) = pair16(oa, ob); }
    } } }
}
template <int MODE, int ND>
__device__ __forceinline__ void moe_load_a(const Params& p, LAS char* L, int la, int lane, int slot0, int rs0, int nrows, int pass0) {
  constexpr int K = MODE ? 512 : D, NST = K / 64;
  const int* rowmap = (const int*)(p.ws + WS_RM2);
  const __amdgpu_buffer_rsrc_t ars = __builtin_amdgcn_make_buffer_rsrc((void*)(p.ws + (MODE ? WS_ACT16 : WS_H2_16)), (short)0, MODE ? (16384 * 512 * 2) : (NTOK * D * 2), 0x00020000);
  const unsigned sc = (unsigned)(lane & 7) ^ (unsigned)((la * 4 + (lane >> 4)) & 7);
  unsigned avo[ND];
#pragma unroll
  for (int i = 0; i < ND; ++i) { int lr = pass0 + 8 * (2 * i + la) + (lane >> 3); if (lr >= nrows) lr = 0;
    avo[i] = (MODE ? (unsigned)(slot0 + lr) * 1024u : (unsigned)(rowmap[rs0 + lr] >> 1) * (unsigned)(D * 2)) + sc * 16u; }
#define MOE_DMA(S, RA) do { _Pragma("unroll") for (int i = 0; i < ND; ++i) \
    __builtin_amdgcn_raw_ptr_buffer_load_lds(ars, (LAS void*)(L + (RA) + (2 * i + la) * 1024), 16, avo[i], (S) * 128, 0, 0); } while (0)
  MOE_DMA(0, 32768);
  MOE_DMA(1, 32768 + 40960);
  if (ND == 20) asm volatile("s_waitcnt vmcnt(20)" ::: "memory"); else if (ND == 16) asm volatile("s_waitcnt vmcnt(16)" ::: "memory"); else asm volatile("s_waitcnt vmcnt(12)" ::: "memory");
  LDS_BARRIER();
  unsigned rn = 32768 + 2 * 40960;
#pragma unroll 1
  for (int s = 0; s < NST; ++s) {
    if (s + 2 < NST) { MOE_DMA(s + 2, rn); rn = (rn == 32768 + 2 * 40960) ? 32768 : rn + 40960;
      if (ND == 20) asm volatile("s_waitcnt vmcnt(20)" ::: "memory"); else if (ND == 16) asm volatile("s_waitcnt vmcnt(16)" ::: "memory"); else asm volatile("s_waitcnt vmcnt(12)" ::: "memory");
    } else asm volatile("s_waitcnt vmcnt(0)" ::: "memory");
    LDS_BARRIER();
  }
#undef MOE_DMA
}
template <int MODE>
__device__ __forceinline__ void moe_unit(const Params& p, char* lds, int e, int nc, int rh) {
  const int tid = threadIdx.x, lane = tid & 63, wid = __builtin_amdgcn_readfirstlane(tid >> 6);
  const LAS int* em = (const LAS int*)((LAS char*)lds + 155648);
  const int tot = __builtin_amdgcn_readfirstlane(em[32 + e]), base = __builtin_amdgcn_readfirstlane(em[64 + e]);
  const int Rh = (((tot + 1) >> 1) + 15) & ~15;
  const int r0 = rh ? Rh : 0, r1 = rh ? tot : (Rh < tot ? Rh : tot);
  const int nrows = r1 - r0, slot0 = base + r0, rs0 = e * 8192 + r0;
  LAS char* L = (LAS char*)lds;
  for (int pass0 = 0; pass0 < nrows; pass0 += 320) {
    const int prow = (nrows - pass0 < 320) ? (nrows - pass0) : 320;
    const int MT = (((prow + 31) >> 5) + 1) >> 1;
    if (wid < 4) {
      if (MT == 5) moe_consume<MODE, 5>(p, L, wid, lane, slot0, rs0, nrows, pass0, e, nc);
      else if (MT == 4) moe_consume<MODE, 4>(p, L, wid, lane, slot0, rs0, nrows, pass0, e, nc);
      else moe_consume<MODE, 3>(p, L, wid, lane, slot0, rs0, nrows, pass0, e, nc);
    } else if (wid < 6) {
      if (MT == 5) moe_load_a<MODE, 20>(p, L, wid - 4, lane, slot0, rs0, nrows, pass0);
      else if (MT == 4) moe_load_a<MODE, 16>(p, L, wid - 4, lane, slot0, rs0, nrows, pass0);
      else moe_load_a<MODE, 12>(p, L, wid - 4, lane, slot0, rs0, nrows, pass0);
    }
  }
}
__device__ __forceinline__ const LAS int* moe_setup(const Params& p, char* lds, int& vb) {
  LAS int* order = (LAS int*)((LAS char*)lds + 155648);
  const unsigned* rk = (const unsigned*)(p.ws + WS_BAR) + XCC_RANK;
  const unsigned* ecnt = (const unsigned*)(p.ws + WS_BAR) + EXP_CNT;
  const int tid = threadIdx.x;
  unsigned rv[8];
#pragma unroll
  for (int j = 0; j < 8; ++j) rv[j] = __hip_atomic_load(rk + 64 * j, __ATOMIC_RELAXED, __HIP_MEMORY_SCOPE_AGENT);
  if (tid < 32) {
    int tv[32];
#pragma unroll
    for (int j = 0; j < 32; ++j) tv[j] = (int)__hip_atomic_load(ecnt + 64 * j, __ATOMIC_RELAXED, __HIP_MEMORY_SCOPE_AGENT);
    int t = 0, rank = 0, base = 0;
#pragma unroll
    for (int j = 0; j < 32; ++j) t = (j == tid) ? tv[j] : t;
#pragma unroll
    for (int j = 0; j < 32; ++j) { const int tj = tv[j]; rank += (tj > t || (tj == t && j < tid)) ? 1 : 0; base += (j < tid) ? tj : 0; }
    order[rank] = tid; order[32 + tid] = t; order[64 + tid] = base; }
  bool ok = gridDim.x == 256;
#pragma unroll
  for (int j = 0; j < 8; ++j) ok = ok & (rv[j] == 32u);
  const volatile LAS unsigned* st = (const volatile LAS unsigned*)(LAS char*)(lds + LDS_MAIN);
  vb = ok ? (int)(st[2] + 8u * st[3]) : -1;
  if (tid == 0) order[96] = vb;
  __syncthreads();
  return order;
}
template <int MODE>
__device__ __forceinline__ bool moe_pick(const LAS int* order, int vb, int r, int& e, int& nc, int& rh) {
  constexpr int NU = MODE ? 1024 : 512;
  const int u = blockIdx.x + r * gridDim.x; if (u >= NU) return false;
  if (MODE == 0) { e = u >> 4; nc = (u >> 1) & 7; rh = u & 1;
    if (vb >= 0) { const int x = vb & 7, i = vb >> 3; e = r * 16 + x * 2 + (i >> 4); nc = (i >> 1) & 7; rh = i & 1; }
    e = __builtin_amdgcn_readfirstlane(order[(e & 16) ? 31 - (e & 15) : (e & 15)]);
  } else { e = u >> 5; nc = (u >> 1) & 15; rh = u & 1;
    if (vb >= 0) { const int x = vb & 7, i = vb >> 3; e = r * 8 + x; nc = i >> 1; rh = i & 1; }
    e = __builtin_amdgcn_readfirstlane(order[(e & 8) ? (e | 7) - (e & 7) : e]); }
  return true;
}
__device__ __forceinline__ int moe_unit_rows(const LAS int* em, int e, int rh) {
  const int tot = __builtin_amdgcn_readfirstlane(em[32 + e]);
  const int Rh = (((tot + 1) >> 1) + 15) & ~15;
  const int r0 = rh ? Rh : 0, r1 = rh ? tot : (Rh < tot ? Rh : tot);
  return r1 - r0;
}
template <int MODE>
__device__ void moe_b_phase(const Params& p, char* lds, int vb, const LAS int* order, int mat, int lane) {
  constexpr int K = MODE ? 512 : D, NST = K / 64, LDB = MODE ? D : 512;
  LAS char* L = (LAS char*)lds;
  const LAS int* em = (const LAS int*)(L + 155648);
  const int nq = lane & 15, kql = lane >> 4, c0 = 4 * nq;
  const unsigned bvo = (unsigned)(4 * kql * LDB + c0) * 4u;
  const int nl = MODE ? (mat * 64 + c0) : ((c0 >> 5) * 64 + mat * 32 + (c0 & 31));
  const unsigned wl = (kql >> 1) * 2048u + (kql & 1) * 8u + nl * 16u;
  u32x4 X[16], Y[16];
#define MOE_BRS(E, NC) __builtin_amdgcn_make_buffer_rsrc((void*)(MODE ? (p.w_down + (size_t)(E) * 512 * D + 128 * (NC) + mat * 64) : ((mat ? p.w_up : p.w_gate) + (size_t)(E) * D * 512 + 64 * (NC))), \
    (short)0, (int)(K * LDB * 4 - 1024), 0x00020000)
#define MOE_LOADB(R, V, S) do { _Pragma("unroll") for (int q = 0; q < 16; ++q) V[q] = __builtin_amdgcn_raw_buffer_load_b128(R, bvo, ((S) * 64 + 16 * (q >> 2) + (q & 3)) * (LDB * 4), 0); } while (0)
#define MOE_STOREB(V, BUF) do { _Pragma("unroll") for (int kg = 0; kg < 4; ++kg) _Pragma("unroll") for (int nn = 0; nn < 4; ++nn) { half4 h; \
      h[0] = (half_t)__uint_as_float(V[kg * 4 + 0][nn]); h[1] = (half_t)__uint_as_float(V[kg * 4 + 1][nn]); h[2] = (half_t)__uint_as_float(V[kg * 4 + 2][nn]); h[3] = (half_t)__uint_as_float(V[kg * 4 + 3][nn]); \
      *(LAS half4*)(L + (BUF) * 16384 + kg * 4096 + wl + ((nn + (nl >> 4)) & 3) * 16) = h; } } while (0)
  bool pre = false;
  for (int r = 0; ; ++r) {
    int e, nc, rh; if (!moe_pick<MODE>(order, vb, r, e, nc, rh)) break;
    const int nrows = moe_unit_rows(em, e, rh);
    const __amdgpu_buffer_rsrc_t brs = MOE_BRS(e, nc);
    for (int pass0 = 0; pass0 < nrows; pass0 += 320) {
      if (!pre) { MOE_LOADB(brs, X, 0); MOE_LOADB(brs, Y, 1); }
      MOE_STOREB(X, 0);
      LDS_BARRIER();
#pragma unroll 1
      for (int s = 0; s < NST - 2; s += 2) {
        MOE_LOADB(brs, X, s + 2); MOE_STOREB(Y, 1); LDS_BARRIER();
        MOE_LOADB(brs, Y, s + 3); MOE_STOREB(X, 0); LDS_BARRIER();
      }
      MOE_STOREB(Y, 1);
      int e2 = e, nc2 = nc; bool have = pass0 + 320 < nrows;
      if (!have) { for (int r2 = r + 1; ; ++r2) { int rh2; if (!moe_pick<MODE>(order, vb, r2, e2, nc2, rh2)) break; if (moe_unit_rows(em, e2, rh2) > 0) { have = true; break; } } }
      if (have) { const __amdgpu_buffer_rsrc_t brs2 = MOE_BRS(e2, nc2); MOE_LOADB(brs2, X, 0); MOE_LOADB(brs2, Y, 1); }
      pre = have;
      LDS_BARRIER();
      LDS_BARRIER();
    }
  }
#undef MOE_BRS
#undef MOE_LOADB
#undef MOE_STOREB
}
__device__ void phase9(const Params& p, char* lds) {
  int vb; const LAS int* order = moe_setup(p, lds, vb);
  const int wid = __builtin_amdgcn_readfirstlane(threadIdx.x >> 6);
  if (wid >= 6) { moe_b_phase<0>(p, lds, vb, order, wid - 6, threadIdx.x & 63); return; }
  for (int r = 0; ; ++r) { int e, nc, rh; if (!moe_pick<0>(order, vb, r, e, nc, rh)) break; moe_unit<0>(p, lds, e, nc, rh); }
}
__device__ void phase10(const Params& p, char* lds) {
  const LAS int* order = (const LAS int*)((LAS char*)lds + 155648);
  if (p.ph_lo == 10) { int v; (void)moe_setup(p, lds, v); }
  const int vb = __builtin_amdgcn_readfirstlane(order[96]);
  const int wid = __builtin_amdgcn_readfirstlane(threadIdx.x >> 6);
  if (wid >= 6) { moe_b_phase<1>(p, lds, vb, order, wid - 6, threadIdx.x & 63); return; }
  for (int r = 0; ; ++r) { int e, nc, rh; if (!moe_pick<1>(order, vb, r, e, nc, rh)) break; moe_unit<1>(p, lds, e, nc, rh); }
}

__device__ void phase11(const Params& p, char* lds) {
  const int tid = threadIdx.x, lane = tid & 63, wid = tid >> 6;
  const float* modf = (const float*)(p.ws + WS_MOD); const half_t* out2 = (const half_t*)(p.ws + WS_OUT2); const half_t* x1h = (const half_t*)(p.ws + WS_X1H);
  for (int rg = blockIdx.x; rg < 256; rg += gridDim.x) {
    const int t0 = rg * 32 + wid * 4, b = t0 >> 11;
    f32x4 gt[4][2], sf[4][2], hf[4][2];
#pragma unroll
    for (int j = 0; j < 4; ++j)
#pragma unroll
      for (int h = 0; h < 2; ++h) { const int c = lane * 8 + 512 * j + 4 * h;
        gt[j][h] = *(const f32x4*)(modf + b * MODN + 10240 + c);
        sf[j][h] = *(const f32x4*)(p.g_final + c) * (*(const f32x4*)(modf + b * MODN + 12288 + 2048 + c) + 1.0f);
        hf[j][h] = *(const f32x4*)(modf + b * MODN + 12288 + c); }
    half8 xv[4], m0[4], m1[4];
#pragma unroll
    for (int j = 0; j < 4; ++j) { const int c = lane * 8 + 512 * j; xv[j] = *(const half8*)(x1h + (size_t)t0 * D + c);
      m0[j] = *(const half8*)(out2 + (size_t)(2 * t0) * D + c); m1[j] = *(const half8*)(out2 + (size_t)(2 * t0 + 1) * D + c); }
#pragma unroll
    for (int i = 0; i < 4; ++i) {
      const int t = t0 + i;
      float x2[4][8]; float ss = 0.f;
#pragma unroll
      for (int j = 0; j < 4; ++j)
#pragma unroll
        for (int e = 0; e < 8; ++e) { const float v = (float)xv[j][e] + gt[j][e >> 2][e & 3] * ((float)m0[j][e] + (float)m1[j][e]); x2[j][e] = v; ss += v * v; }
      if (i < 3) {
#pragma unroll
        for (int j = 0; j < 4; ++j) { const int c = lane * 8 + 512 * j; xv[j] = *(const half8*)(x1h + (size_t)(t + 1) * D + c);
          m0[j] = *(const half8*)(out2 + (size_t)(2 * t + 2) * D + c); m1[j] = *(const half8*)(out2 + (size_t)(2 * t + 3) * D + c); }
      }
      ss = wave_sum(ss);
      const float rstd = rsqrtf(ss * (1.0f / D) + EPS);
      float* xr = p.out + (size_t)t * D;
#pragma unroll
      for (int j = 0; j < 4; ++j)
#pragma unroll
        for (int h = 0; h < 2; ++h) { f32x4 o;
#pragma unroll
          for (int e = 0; e < 4; ++e) o[e] = x2[j][4 * h + e] * rstd * sf[j][h][e] + hf[j][h][e];
          *(f32x4*)(xr + lane * 8 + 512 * j + 4 * h) = o; }
    }
  }
}


#define XB_TMO      128
#define XB_XCNT(j)  (256  + 64 * (j))
#define XB_XSUB(j)  (1280 + 64 * (j))
#define XB_XGEN(j)  (2304 + 64 * (j))
#define XB_TOP      3328
#define XB_TOPGEN   3392
#define XCD_BAR_WORDS 3456
#define XB_SPIN_CAP (1u << 25)
__device__ __forceinline__ unsigned xb_ld(unsigned* p) { return __hip_atomic_load(p, __ATOMIC_RELAXED, __HIP_MEMORY_SCOPE_AGENT); }
__device__ __forceinline__ unsigned xb_add(unsigned* p, unsigned v) { return __hip_atomic_fetch_add(p, v, __ATOMIC_RELAXED, __HIP_MEMORY_SCOPE_AGENT); }
__device__ __forceinline__ unsigned xb_xcc_id() { return (unsigned)__builtin_amdgcn_s_getreg((3 << 11) | 20) & 0xFu; }
#define XB_SPIN(cond, bar) do { unsigned _sp = 0; while (cond) { __builtin_amdgcn_s_sleep(1); \
    if ((++_sp & 255u) == 0u) { if (xb_ld(&(bar)[XB_TMO])) break; if (_sp > XB_SPIN_CAP) { atomicAdd(&(bar)[XB_TMO], 1u); break; } } } } while (0)
struct XcdBarrier { unsigned* bar; unsigned x; volatile LAS unsigned* st; };
__device__ __forceinline__ XcdBarrier xcd_barrier_post(unsigned* bar, volatile LAS unsigned* st) {
  XcdBarrier b; b.bar = bar; b.x = xb_xcc_id(); b.st = st;
  if (threadIdx.x == 0) (void)xb_add(&bar[XB_XCNT(b.x)], 1u);
  return b;
}
__device__ __forceinline__ void xcd_barrier_complete(unsigned* bar, unsigned x, unsigned& nloc, unsigned& nx) {
  const unsigned G = gridDim.x * gridDim.y * gridDim.z;
  unsigned sum, cnt, mine, sp = 0u;
  for (;;) {
    sum = 0u; cnt = 0u; mine = 0u;
#pragma unroll
    for (unsigned j = 0; j < 16; ++j) { const unsigned c = xb_ld(&bar[XB_XCNT(j)]); sum += c; cnt += (c > 0u) ? 1u : 0u; mine = (j == x) ? c : mine; }
    if (sum == G) break;
    __builtin_amdgcn_s_sleep(1);
    if ((++sp & 255u) == 0u) { if (xb_ld(&bar[XB_TMO])) break; if (sp > XB_SPIN_CAP) { atomicAdd(&bar[XB_TMO], 1u); break; } }
  }
  nloc = mine > 0u ? mine : 1u; nx = cnt > 0u ? cnt : 1u;
}
__device__ __forceinline__ void xcd_barrier(const XcdBarrier& b) {
  asm volatile("s_waitcnt vmcnt(0)" ::: "memory");
  __syncthreads();
  if (threadIdx.x == 0) {
    unsigned* bar = b.bar;
    __builtin_amdgcn_s_waitcnt(0);
    unsigned nloc = b.st[0], nx = b.st[1];
    if (nloc == 0u) { xcd_barrier_complete(bar, b.x, nloc, nx); b.st[0] = nloc; b.st[1] = nx; }
    const unsigned old = xb_add(&bar[XB_XSUB(b.x)], 1u);
    const unsigned gen = old / nloc;
    if (old + 1u == (gen + 1u) * nloc) {
      __builtin_amdgcn_fence(__ATOMIC_RELEASE, "agent");
      asm volatile("s_waitcnt vmcnt(0)" ::: "memory");
      const unsigned og = xb_add(&bar[XB_TOP], 1u);
      const unsigned tg = og / nx;
      if (og + 1u == (tg + 1u) * nx) xb_add(&bar[XB_TOPGEN], 1u);
      else XB_SPIN(xb_ld(&bar[XB_TOPGEN]) == tg, bar);
      __builtin_amdgcn_fence(__ATOMIC_ACQUIRE, "agent");
      xb_add(&bar[XB_XGEN(b.x)], 1u);
      asm volatile("s_waitcnt vmcnt(0)" ::: "memory");
    } else {
      XB_SPIN(xb_ld(&bar[XB_XGEN(b.x)]) == gen, bar);
      __builtin_amdgcn_fence(__ATOMIC_ACQUIRE, "agent");
      asm volatile("s_waitcnt vmcnt(0)" ::: "memory");
    }
  }
  __syncthreads();
}

__global__ void __launch_bounds__(NT) mega(Params p) {
  extern __shared__ __attribute__((aligned(16))) char smem[];
  volatile LAS unsigned* st = (volatile LAS unsigned*)(LAS char*)(smem + LDS_MAIN);
  if (threadIdx.x < 4) st[threadIdx.x] = 0u;
  __syncthreads();
  XcdBarrier bar = xcd_barrier_post((unsigned*)(p.ws + WS_BAR), st);
  if (threadIdx.x == 0) { st[2] = bar.x; st[3] = xb_add((unsigned*)(p.ws + WS_BAR) + XCC_RANK + 64 * bar.x, 1u); }
  __syncthreads();
  const int lo = p.ph_lo, hi = p.ph_hi;
#define PH(k, call) if (lo <= (k) && (k) < hi) { call; if ((k) + 1 < hi) xcd_barrier(bar); }
  PH(0, phase0(p, smem))
  PH(1, phase1(p, smem))
  PH(2, phase2(p, smem))
  PH(3, phase3(p, smem))
  PH(4, phase4(p, smem))
  PH(6, phase6(p, smem))
  PH(7, phase7(p, smem))
  PH(9, phase9(p, smem))
  PH(10, phase10(p, smem))
  PH(11, phase11(p, smem))
#undef PH
}

extern "C" void kernel_launch(void* const* d_in, const int* in_sizes, int n_in, void* d_out, int out_size, void* d_ws, size_t ws_size, hipStream_t stream) {
  if (n_in != 24 || ws_size < WS_END) { fprintf(stderr, "kernel_launch: need 24 inputs and %zu bytes of workspace (got %d, %zu)\n", (size_t)WS_END, n_in, ws_size); return; }
  static int grid = 0;
  if (grid == 0) {
    int dev = 0, cus = 0, per_cu = 0;
    (void)hipGetDevice(&dev);
    (void)hipDeviceGetAttribute(&cus, hipDeviceAttributeMultiprocessorCount, dev);
    (void)hipFuncSetAttribute((const void*)mega, hipFuncAttributeMaxDynamicSharedMemorySize, LDS_BYTES);
    (void)hipOccupancyMaxActiveBlocksPerMultiprocessor(&per_cu, (const void*)mega, NT, LDS_BYTES);
    if (per_cu < 1) { fprintf(stderr, "kernel_launch: occupancy query says %d blocks per CU\n", per_cu); grid = -1; return; }
    grid = cus;
  }
  if (grid < 0) return;
  (void)hipMemsetAsync((char*)d_ws + WS_BAR, 0, 32768, stream);
  Params p{};
  const float** pp = (const float**)&p;
  for (int i = 0; i < 24; ++i) pp[i] = (const float*)d_in[i];
  p.out = (float*)d_out; p.ws = (char*)d_ws; p.ph_lo = 0; p.ph_hi = 12;
#ifdef PROBE_PHASE
  {
    p.ph_hi = PROBE_PHASE + 1;
    void* a1[] = {&p};
    (void)hipLaunchCooperativeKernel((const void*)mega, dim3(grid), dim3(NT), a1, LDS_BYTES, stream);
    (void)hipMemsetAsync((char*)d_ws + WS_BAR, 0, 32768, stream);
    p.ph_lo = PROBE_PHASE; p.ph_hi = 12;
  }
#endif
#ifdef PROBE_SUB
  {
    p.ph_hi = 4;
    void* a1[] = {&p};
    (void)hipLaunchCooperativeKernel((const void*)mega, dim3(grid), dim3(NT), a1, LDS_BYTES, stream);
    (void)hipMemsetAsync((char*)d_ws + WS_BAR, 0, 32768, stream);
    p.ph_lo = 3; p.ph_hi = 4; p.sub = PROBE_SUB;
    (void)hipLaunchCooperativeKernel((const void*)mega, dim3(grid), dim3(NT), a1, LDS_BYTES, stream);
    (void)hipMemsetAsync((char*)d_ws + WS_BAR, 0, 32768, stream);
    p.ph_lo = 4; p.ph_hi = 12; p.sub = 0;
  }
#endif
  void* args[] = {&p};
  hipError_t e = hipLaunchCooperativeKernel((const void*)mega, dim3(grid), dim3(NT), args, LDS_BYTES, stream);
  if (e != hipSuccess) fprintf(stderr, "cooperative launch failed: %s (grid %d)\n", hipGetErrorString(e), grid);
}
```
